# Optimizing an MI355X kernel written in HIP

```python
import jax, jax.numpy as jnp
from jax import lax
import numpy as np

D_MODEL = 1024
BATCH = 16
SEQ = 2048
DEPTH = 1

N_MEM = 256
EPS = 1e-6
POOL_WINDOWS = (2, 4, 8, 16)
N_POOL_GROUPS = len(POOL_WINDOWS)
POOL_WIDTH = D_MODEL // 2
POOL_GC = POOL_WIDTH // N_POOL_GROUPS
FOX_HEADS = 8
FOX_DH = 64
FOX_WIDTH = FOX_HEADS * FOX_DH
Q_BLOCK = 128
GATE_WIDTH = 2 * D_MODEL
IN_SPLITS = (POOL_WIDTH, POOL_WIDTH + FOX_WIDTH, POOL_WIDTH + 2 * FOX_WIDTH,
             POOL_WIDTH + 3 * FOX_WIDTH, POOL_WIDTH + 3 * FOX_WIDTH + FOX_HEADS)
IN_COLS = POOL_WIDTH + 3 * FOX_WIDTH + FOX_HEADS + GATE_WIDTH
X_HEADS = 4
X_DH = 128
X_WIDTH = X_HEADS * X_DH
D_FF = ((8 * D_MODEL // 3 + 255) // 256) * 256

kernel_name = "hybrid_pool_fox_gated_block"


def rmsnorm(x, g):
    xf = x.astype(jnp.float32)
    y = xf * lax.rsqrt(jnp.mean(xf * xf, axis=-1, keepdims=True) + EPS)
    return (y * g.astype(jnp.float32)).astype(x.dtype)


def pool_mixer(u, pool_w, pool_scale):
    B, S, _ = u.shape
    uf = u.astype(jnp.float32)
    cs = jnp.cumsum(uf, axis=1)
    t = jnp.arange(S)
    outs = []
    for g, w in enumerate(POOL_WINDOWS):
        sl = slice(g * POOL_GC, (g + 1) * POOL_GC)
        cs_g = cs[..., sl]
        shifted = jnp.pad(cs_g, ((0, 0), (w, 0), (0, 0)))[:, :S]
        cnt = jnp.minimum(t + 1, w).astype(jnp.float32)[None, :, None]
        outs.append((cs_g - shifted) / cnt - uf[..., sl])
    d = jnp.stack(outs, axis=2).astype(u.dtype)
    y = jnp.einsum('bsgc,gcd->bsgd', d, pool_w).reshape(B, S, POOL_WIDTH)
    return y * pool_scale


def forgetting_attention(q, k, v, f_logit):
    B, S, H, dh = q.shape
    q = q.transpose(0, 2, 1, 3)
    k = k.transpose(0, 2, 1, 3)
    v = v.transpose(0, 2, 1, 3)
    c = jnp.cumsum(jax.nn.log_sigmoid(f_logit.astype(jnp.float32)), axis=1).transpose(0, 2, 1)
    scale = dh ** -0.5
    outs = []
    for i in range(S // Q_BLOCK):
        q0, q1 = i * Q_BLOCK, (i + 1) * Q_BLOCK
        qb = q[:, :, q0:q1]
        kp, vp, cp = k[:, :, :q1], v[:, :, :q1], c[:, :, :q1]
        s = jnp.einsum('bhqd,bhkd->bhqk', qb, kp).astype(jnp.float32) * scale
        s = s + c[:, :, q0:q1, None] - cp[:, :, None, :]
        mask = (q0 + jnp.arange(Q_BLOCK))[:, None] >= jnp.arange(q1)[None, :]
        s = jnp.where(mask[None, None], s, -1e30)
        p = jax.nn.softmax(s, axis=-1).astype(v.dtype)
        outs.append(jnp.einsum('bhqk,bhkd->bhqd', p, vp))
    o = jnp.concatenate(outs, axis=2)
    return o.transpose(0, 2, 1, 3).reshape(B, S, H * dh)


def memory_cross_attention(h, mem_n, w_xq, w_xkv, w_xo):
    B, S, _ = h.shape
    M = mem_n.shape[1]
    q = (h @ w_xq).reshape(B, S, X_HEADS, X_DH)
    kv = (mem_n @ w_xkv).reshape(B, M, 2, X_HEADS, X_DH)
    k, v = kv[:, :, 0], kv[:, :, 1]
    s = jnp.einsum('bshd,bmhd->bhsm', q, k).astype(jnp.float32) * (X_DH ** -0.5)
    p = jax.nn.softmax(s, axis=-1).astype(v.dtype)
    o = jnp.einsum('bhsm,bmhd->bshd', p, v).reshape(B, S, X_WIDTH)
    return o @ w_xo


def setup_inputs(seed: int = 0) -> dict:
    key = jax.random.key(seed)
    ks = jax.random.split(key, 24)
    f32 = jnp.float32

    def nrm(k, shape, fan_in):
        return jax.random.normal(k, shape, f32) * (fan_in ** -0.5)

    def gain(k, shape):
        return 1.0 + 0.05 * jax.random.normal(k, shape, f32)

    L = DEPTH
    return {
        "x": jax.random.normal(ks[0], (BATCH, SEQ, D_MODEL), f32),
        "mem": jax.random.normal(ks[1], (BATCH, N_MEM, D_MODEL), f32),
        "norm_mix_g": gain(ks[2], (L, D_MODEL)),
        "w_in": nrm(ks[3], (L, D_MODEL, IN_COLS), D_MODEL),
        "b_forget": 3.0 + 0.5 * jax.random.normal(ks[4], (L, FOX_HEADS), f32),
        "b_gate": 0.02 * jax.random.normal(ks[5], (L, GATE_WIDTH), f32),
        "pool_w": nrm(ks[6], (L, N_POOL_GROUPS, POOL_GC, POOL_GC), POOL_GC),
        "pool_scale": gain(ks[7], (L, POOL_WIDTH)),
        "w_pool_out": nrm(ks[8], (L, POOL_WIDTH, D_MODEL), POOL_WIDTH),
        "w_fox_out": nrm(ks[9], (L, FOX_WIDTH, D_MODEL), FOX_WIDTH),
        "w_out": nrm(ks[10], (L, D_MODEL, D_MODEL), D_MODEL),
        "norm_x_g": gain(ks[11], (L, D_MODEL)),
        "norm_mem_g": gain(ks[12], (L, D_MODEL)),
        "w_xq": nrm(ks[13], (L, D_MODEL, X_WIDTH), D_MODEL),
        "w_xkv": nrm(ks[14], (L, D_MODEL, 2 * X_WIDTH), D_MODEL),
        "w_xo": nrm(ks[15], (L, X_WIDTH, D_MODEL), X_WIDTH),
        "norm_ffn_g": gain(ks[16], (L, D_MODEL)),
        "w_ffn_in": nrm(ks[17], (L, D_MODEL, 2 * D_FF), D_MODEL),
        "w_ffn_out": nrm(ks[18], (L, D_FF, D_MODEL), D_FF),
        "norm_final_g": gain(ks[19], (D_MODEL,)),
    }


def reference(x, mem, norm_mix_g, w_in, b_forget, b_gate, pool_w, pool_scale,
              w_pool_out, w_fox_out, w_out, norm_x_g, norm_mem_g, w_xq, w_xkv, w_xo,
              norm_ffn_g, w_ffn_in, w_ffn_out, norm_final_g):
    B, S, D = x.shape
    for l in range(DEPTH):
        h = rmsnorm(x, norm_mix_g[l])
        proj = h @ w_in[l]
        u_pool, q, k, v, f_logit, g_logit = jnp.split(proj, IN_SPLITS, axis=-1)
        y_pool = pool_mixer(u_pool, pool_w[l], pool_scale[l]) @ w_pool_out[l]
        y_fox = forgetting_attention(q.reshape(B, S, FOX_HEADS, FOX_DH),
                                     k.reshape(B, S, FOX_HEADS, FOX_DH),
                                     v.reshape(B, S, FOX_HEADS, FOX_DH),
                                     f_logit + b_forget[l]) @ w_fox_out[l]
        gates = jax.nn.sigmoid(g_logit + b_gate[l])
        g_pool, g_fox = gates[..., :D], gates[..., D:]
        x = x + (g_pool * y_pool + g_fox * y_fox) @ w_out[l]
        hx = rmsnorm(x, norm_x_g[l])
        mem_n = rmsnorm(mem, norm_mem_g[l])
        x = x + memory_cross_attention(hx, mem_n, w_xq[l], w_xkv[l], w_xo[l])
        hf = rmsnorm(x, norm_ffn_g[l])
        gu = hf @ w_ffn_in[l]
        gt, up = gu[..., :D_FF], gu[..., D_FF:]
        x = x + (jax.nn.silu(gt) * up) @ w_ffn_out[l]
    return rmsnorm(x, norm_final_g)
```

```cpp
#include <hip/hip_runtime.h>
#include <hip/hip_cooperative_groups.h>
#include <cstdio>
#include <cstdint>
namespace cg = cooperative_groups;
__device__ __forceinline__ int hw_lane() { int l = (int)__builtin_amdgcn_mbcnt_hi(~0u, __builtin_amdgcn_mbcnt_lo(~0u, 0u)); asm volatile("" : "+v"(l)); return l; }
namespace pg8 {
#define PG8_LAS __attribute__((address_space(3)))
typedef unsigned short bf16_t;
typedef short bf16x8 __attribute__((ext_vector_type(8)));
typedef float f32x4 __attribute__((ext_vector_type(4)));
typedef unsigned u32x4 __attribute__((ext_vector_type(4)));
constexpr int BM = 256, BK = 64, HALF = 128, HTB = HALF * BK * 2  , STAGE_BYTES = 8 * HTB, NXCD = 8, WGM = 8;

__host__ __device__ __forceinline__ int lds_byte(int r, int c) { const int st = (r >> 4) * 2 + (c >> 5), rr = r & 15, cc = c & 31, ob = rr * 64 + cc * 2; return st * 1024 + (ob ^ (((ob >> 9) & 1) << 5)); }
__host__ __device__ __forceinline__ void stage_rc(int b, int& R, int& C) { const int st = b / 1024, sb = b % 1024, swz = sb ^ (((sb >> 9) & 1) << 5); R = (st >> 1) * 16 + swz / 64; C = (st & 1) * 32 + (swz % 64) / 2; }
__host__ __device__ __forceinline__ int perm32(int rho) { const int n = rho >> 4, i = rho & 15; return 8 * (i >> 2) + 4 * n + (i & 3); }

struct Unit { int pm, pn; };
struct Gemm { const bf16_t* A; const bf16_t* Bt; int M, N, K; };

struct StaticOrder {
    int nM, nN, nwg, G, c;
    __host__ __device__ void init(int M, int N, int G_, int c_) { nM = M / BM; nN = N / BM; nwg = nM * nN; G = G_; c = c_; }
    __host__ __device__ bool next(int i, Unit& u) const {
        const long L = (long)i * G + c; if (L >= nwg) return false;
        int wgid = (int)L; { const int q = nwg / NXCD, r = nwg % NXCD, xcd = wgid % NXCD, off = wgid / NXCD; wgid = (xcd < r ? xcd * (q + 1) : r * (q + 1) + (xcd - r) * q) + off; }
        const int nig = WGM * nN, gid = wgid / nig, fm = gid * WGM, gsz = (nM - fm) < WGM ? (nM - fm) : WGM;
        u.pm = fm + ((wgid % nig) % gsz); u.pn = (wgid % nig) / gsz; return true;
    }
    __device__ __forceinline__ void a_ready(const Unit&) const {}
    __device__ __forceinline__ void done(const Unit&) const {}
};

__device__ __forceinline__ unsigned cvt_pk_bf16(float lo, float hi) { unsigned r; asm volatile("v_cvt_pk_bf16_f32 %0, %1, %2" : "=v"(r) : "v"(lo), "v"(hi)); return r; }
template <class Epi, class Sched, bool ALIGN_EPI = false, bool SP2 = false>
__device__ __forceinline__ void gemm_phase(PG8_LAS unsigned char* lds, const Gemm g, const Sched& S, const Epi& E, const int wv) {
    const int wid = wv, lane = hw_lane(), tid = wid * 64 + lane, wr = wid >> 2, wc = wid & 3, fr = lane & 15, fq = lane >> 4;
    const int K = g.K, nt = K / BK;
    unsigned voffA[2], voffB[2];
#pragma unroll
    for (int i = 0; i < 2; ++i) { int R, C; stage_rc(tid * 16 + i * 8192, R, C); const int Rb = Epi::PERM ? ((R & ~31) + perm32(R & 31)) : R;
        voffA[i] = (unsigned)(R * K + C) * 2u; voffB[i] = (unsigned)(Rb * K + C) * 2u; }
    const size_t kstep = (size_t)(BK * 2);
    const size_t hstep = (size_t)HALF * K * 2;
    const size_t tstep = 2 * hstep;
    const unsigned ldsw = (unsigned)wid * 1024u;
    const int aoff = lds_byte(wr * 64 + fr, fq * 8), boff = lds_byte(wc * 32 + fr, fq * 8);
#define PG8_SA(b, h) (((b) * 2 + (h)) * HTB)
#define PG8_SB(b, h) ((4 + (b) * 2 + (h)) * HTB)
#define PG8_STAGE(bufoff, gbase, voff) do { _Pragma("unroll") for (int _i = 0; _i < 2; ++_i) \
        __builtin_amdgcn_global_load_lds((const unsigned*)((const char*)(gbase) + (voff)[_i]), (PG8_LAS unsigned*)(lds + (bufoff) + ldsw + _i * 8192), 16, 0, 0); } while (0)
#define PG8_LDA(dst, b, h) do { _Pragma("unroll") for (int m = 0; m < 4; ++m) _Pragma("unroll") for (int k = 0; k < 2; ++k) dst[m][k] = *(const PG8_LAS bf16x8*)(lds + PG8_SA(b, h) + aoff + m * 2048 + k * 1024); } while (0)
#define PG8_LDB(dst, b, h) do { _Pragma("unroll") for (int n = 0; n < 2; ++n) _Pragma("unroll") for (int k = 0; k < 2; ++k) dst[n][k] = *(const PG8_LAS bf16x8*)(lds + PG8_SB(b, h) + boff + n * 2048 + k * 1024); } while (0)
#define PG8_MMA(ai, bj, At, Bt) do { __builtin_amdgcn_s_setprio(1); _Pragma("unroll") for (int m = 0; m < 4; ++m) _Pragma("unroll") for (int n = 0; n < 2; ++n) _Pragma("unroll") for (int k = 0; k < 2; ++k) \
        acc[ai][bj][m][n] = __builtin_amdgcn_mfma_f32_16x16x32_bf16(Bt[n][k], At[m][k], acc[ai][bj][m][n], 0, 0, 0); __builtin_amdgcn_s_setprio(0); } while (0)
#define PG8_WAIT_V(n) asm volatile("s_waitcnt vmcnt(" #n ")" ::: "memory")
#define PG8_WAIT_L(n) asm volatile("s_waitcnt lgkmcnt(" #n ")" ::: "memory")
#define PG8_BAR __builtin_amdgcn_s_barrier()
#define PG8_SCHED __builtin_amdgcn_sched_barrier(0)
    Unit cur, nxt; int ui = 0;
    if (!S.next(0, cur)) return;
    f32x4 acc[2][2][4][2];
#pragma unroll
    for (int a = 0; a < 2; ++a)
#pragma unroll
        for (int b = 0; b < 2; ++b)
#pragma unroll
            for (int m = 0; m < 4; ++m)
#pragma unroll
                for (int n = 0; n < 2; ++n) acc[a][b][m][n] = (f32x4){0.f, 0.f, 0.f, 0.f};
    bf16x8 At[4][2], B0[2][2], B1[2][2];
    const char* cA = (const char*)g.A + (size_t)cur.pm * tstep; const char* cB = (const char*)g.Bt + (size_t)cur.pn * tstep;
    S.a_ready(cur);
    if constexpr (SP2) {
        PG8_STAGE(PG8_SB(0, 0), cB, voffB); PG8_STAGE(PG8_SB(0, 1), cB + hstep, voffB); PG8_STAGE(PG8_SA(0, 0), cA, voffA); PG8_STAGE(PG8_SA(0, 1), cA + hstep, voffA);
        if (wr == 1) PG8_BAR;
        PG8_WAIT_V(2); PG8_BAR;
        PG8_STAGE(PG8_SB(1, 0), cB + kstep, voffB); PG8_STAGE(PG8_SA(1, 0), cA + kstep, voffA); PG8_STAGE(PG8_SB(1, 1), cB + hstep + kstep, voffB);
        PG8_WAIT_V(6); PG8_BAR;
    } else {
        PG8_STAGE(PG8_SB(0, 0), cB, voffB); PG8_STAGE(PG8_SA(0, 0), cA, voffA); PG8_STAGE(PG8_SB(0, 1), cB + hstep, voffB); PG8_STAGE(PG8_SA(0, 1), cA + hstep, voffA);
        if (wr == 1) PG8_BAR;
        PG8_WAIT_V(4); PG8_BAR;
        PG8_STAGE(PG8_SB(1, 0), cB + kstep, voffB); PG8_STAGE(PG8_SA(1, 0), cA + kstep, voffA); PG8_STAGE(PG8_SB(1, 1), cB + hstep + kstep, voffB);
        PG8_WAIT_V(6); PG8_BAR;
    }
    for (;;) {
        const bool has_next = S.next(ui + 1, nxt);
        const char* nA = has_next ? (const char*)g.A + (size_t)nxt.pm * tstep : cA; const char* nB = has_next ? (const char*)g.Bt + (size_t)nxt.pn * tstep : cB;
        for (int t = 0; t < nt; t += 2) {
            if constexpr (Epi::HAS_MID) { if (t == (nt >> 1)) E.mid(acc, cur, wr, wc, fr, fq); }
            const bool last = (t == nt - 2);
            const char* a1 = cA + (size_t)(t + 1) * kstep;
            const char* a2 = last ? nA : cA + (size_t)(t + 2) * kstep; const char* b2 = last ? nB : cB + (size_t)(t + 2) * kstep;
            const char* a3 = a2 + kstep; const char* b3 = b2 + kstep;
            if (last && has_next) S.a_ready(nxt);
            if constexpr (SP2) {
            PG8_LDB(B0, 0, 0); PG8_LDB(B1, 0, 1); PG8_SCHED; PG8_LDA(At, 0, 0); PG8_STAGE(PG8_SA(1, 1), a1 + hstep, voffA);
            PG8_WAIT_V(8); PG8_WAIT_L(0); PG8_BAR; PG8_MMA(0, 0, At, B0); PG8_MMA(0, 1, At, B1); PG8_BAR; PG8_SCHED;
            PG8_LDA(At, 0, 1); PG8_STAGE(PG8_SB(0, 0), b2, voffB); PG8_STAGE(PG8_SB(0, 1), b2 + hstep, voffB); PG8_STAGE(PG8_SA(0, 0), a2, voffA);
            PG8_WAIT_V(8); PG8_WAIT_L(0); PG8_BAR; PG8_MMA(1, 0, At, B0); PG8_MMA(1, 1, At, B1); PG8_BAR; PG8_SCHED;
            PG8_LDB(B0, 1, 0); PG8_LDB(B1, 1, 1); PG8_SCHED; PG8_LDA(At, 1, 0); PG8_STAGE(PG8_SA(0, 1), a2 + hstep, voffA);
            PG8_WAIT_V(8); PG8_WAIT_L(0); PG8_BAR; PG8_MMA(0, 0, At, B0); PG8_MMA(0, 1, At, B1); PG8_BAR; PG8_SCHED;
            PG8_LDA(At, 1, 1); PG8_STAGE(PG8_SB(1, 0), b3, voffB); PG8_STAGE(PG8_SB(1, 1), b3 + hstep, voffB); PG8_STAGE(PG8_SA(1, 0), a3, voffA);
            PG8_WAIT_V(8); PG8_WAIT_L(0); PG8_BAR; PG8_MMA(1, 0, At, B0); PG8_MMA(1, 1, At, B1); PG8_BAR; PG8_SCHED;
            } else {
            PG8_LDB(B0, 0, 0); PG8_SCHED; PG8_LDA(At, 0, 0); PG8_STAGE(PG8_SA(1, 1), a1 + hstep, voffA);
            PG8_WAIT_L(8); PG8_BAR; PG8_WAIT_L(0); PG8_MMA(0, 0, At, B0); PG8_BAR; PG8_SCHED;
            PG8_LDB(B1, 0, 1); PG8_STAGE(PG8_SB(0, 0), b2, voffB);
            PG8_BAR; PG8_WAIT_L(0); PG8_MMA(0, 1, At, B1); PG8_BAR;
            PG8_LDA(At, 0, 1); PG8_STAGE(PG8_SA(0, 0), a2, voffA);
            PG8_BAR; PG8_WAIT_L(0); PG8_MMA(1, 0, At, B0); PG8_BAR; PG8_SCHED;
            PG8_STAGE(PG8_SB(0, 1), b2 + hstep, voffB);
            PG8_WAIT_V(6); PG8_BAR; PG8_MMA(1, 1, At, B1); PG8_BAR;
            PG8_LDB(B0, 1, 0); PG8_SCHED; PG8_LDA(At, 1, 0); PG8_STAGE(PG8_SA(0, 1), a2 + hstep, voffA);
            PG8_WAIT_L(8); PG8_BAR; PG8_WAIT_L(0); PG8_MMA(0, 0, At, B0); PG8_BAR; PG8_SCHED;
            PG8_LDB(B1, 1, 1); PG8_STAGE(PG8_SB(1, 0), b3, voffB);
            PG8_BAR; PG8_WAIT_L(0); PG8_MMA(0, 1, At, B1); PG8_BAR;
            PG8_LDA(At, 1, 1); PG8_STAGE(PG8_SA(1, 0), a3, voffA);
            PG8_BAR; PG8_WAIT_L(0); PG8_MMA(1, 0, At, B0); PG8_BAR; PG8_SCHED;
            PG8_STAGE(PG8_SB(1, 1), b3 + hstep, voffB);
            PG8_WAIT_V(6); PG8_BAR; PG8_MMA(1, 1, At, B1); PG8_BAR;
            }
        }
        if constexpr (ALIGN_EPI) { if (wr == 0) PG8_BAR; }
        if constexpr (!Epi::AFTER_DRAIN) { E(acc, cur, wr, wc, fr, fq); S.done(cur); }
        if (!has_next) break;
#pragma unroll
        for (int a = 0; a < 2; ++a)
#pragma unroll
            for (int b = 0; b < 2; ++b)
#pragma unroll
                for (int m = 0; m < 4; ++m)
#pragma unroll
                    for (int n = 0; n < 2; ++n) acc[a][b][m][n] = (f32x4){0.f, 0.f, 0.f, 0.f};
        cur = nxt; cA = nA; cB = nB; ++ui;
        if constexpr (ALIGN_EPI) { if (wr == 1) PG8_BAR; }
    }
    PG8_WAIT_V(0);
    if constexpr (!ALIGN_EPI) { if (wr == 0) PG8_BAR; }
    PG8_BAR;
    if constexpr (Epi::AFTER_DRAIN) { E.fused(acc, cur, wr, wc, fr, fq, lds, wid, lane); S.done(cur); }
#undef PG8_SA
#undef PG8_SB
#undef PG8_STAGE
#undef PG8_LDA
#undef PG8_LDB
#undef PG8_MMA
#undef PG8_WAIT_V
#undef PG8_WAIT_L
#undef PG8_BAR
#undef PG8_SCHED
}
}
#ifndef PG8_SP2
#define PG8_SP2 true
#endif
#ifndef PG8_ALIGN
#define PG8_ALIGN true
#endif
#include <hip/hip_bf16.h>
#include <cmath>
namespace attn_body {
using bf16=__hip_bfloat16;
using bf16x8=__attribute__((ext_vector_type(8)))short;
using s16x4=__attribute__((ext_vector_type(4)))short;
using f32x16=__attribute__((ext_vector_type(16)))float;
using u32x4=__attribute__((ext_vector_type(4)))unsigned;
constexpr int BATCH=16,NHEAD=8,SEQ=2048,D=64,DM=NHEAD*D,ODM=1024;
constexpr int NW=8,QBLK=32,QB=QBLK*NW,KVBLK=64,NQB=SEQ/QB;
constexpr int ATTN_PITCH=DM, ATTN_UNIT_ROWS=QB;
__device__ __forceinline__ int crow(int r,int hi){return (r&3)+8*(r>>2)+4*hi;}
#define SBAR() __builtin_amdgcn_sched_barrier(0)
__device__ __forceinline__ void cmask(f32x16&p0,f32x16&p1,int jb,int qrel,int hi){
  const float NEG=-INFINITY; int kb=64*jb+4*hi;
  #pragma unroll
  for(int r=0;r<16;++r){int kv=kb+(r&3)+8*(r>>2); if(kv>qrel)p0[r]=NEG; if(kv+32>qrel)p1[r]=NEG;}
}

constexpr int NSLOT=3, SLOTB=8192;
constexpr int LDS_K=0, LDS_V=NSLOT*SLOTB, LDS_WS=2*NSLOT*SLOTB, LDS_OST=LDS_WS+NW*64*4, LDS_CB=LDS_OST+NW*4096, LDS_CL=LDS_CB+SEQ*4, LDS_BYTES=LDS_CL+SEQ*4;
constexpr float C2=0.125f*1.4426950408889634f;
__device__ __forceinline__ void glds16(const void*gsrc,unsigned lds_dst){unsigned keep;
  asm volatile("s_mov_b32 %0, m0\n\ts_mov_b32 m0, %2\n\ts_nop 0\n\tglobal_load_lds_dwordx4 %1, off\n\ts_mov_b32 m0, %0":"=&s"(keep):"v"(gsrc),"s"(lds_dst):"memory");}
__device__ __forceinline__ float max3f(float a,float b,float c){float r;asm("v_max3_f32 %0, %1, %2, %3":"=v"(r):"v"(a),"v"(b),"v"(c));return r;}
__device__ __forceinline__ float max2f(float a,float b){float r;asm("v_max_f32_e32 %0, %1, %2":"=v"(r):"v"(a),"v"(b));return r;}
__device__ __forceinline__ float fadd_s(float a,float b){float r;asm("v_add_f32_e32 %0, %1, %2":"=v"(r):"v"(a),"v"(b));return r;}
__device__ __forceinline__ float fsub_s(float a,float b){float r;asm("v_sub_f32_e32 %0, %1, %2":"=v"(r):"v"(a),"v"(b));return r;}
typedef float f32x2_t __attribute__((ext_vector_type(2))); typedef __bf16 bf16x2_t __attribute__((ext_vector_type(2)));
__device__ __forceinline__ unsigned cvtpk_s(float lo,float hi){f32x2_t v={lo,hi};bf16x2_t b=__builtin_convertvector(v,bf16x2_t);return __builtin_bit_cast(unsigned,b);}
#define WAIT_BAR(N) asm volatile("s_waitcnt vmcnt(" #N ") lgkmcnt(0)\n\ts_barrier":::"memory")

__device__ __forceinline__ void qkt(f32x16&p0,f32x16&p1,const char*Kslot,const bf16x8*qr,const f32x16&negm,int r32,int hi){
  const char*kb=Kslot+hi*1024+r32*16;
  #pragma unroll
  for(int d0=0;d0<4;++d0){
    const bf16x8 b0=*reinterpret_cast<const bf16x8*>(kb+d0*2048);
    const bf16x8 b1=*reinterpret_cast<const bf16x8*>(kb+d0*2048+512);
    if(d0==0){p0=__builtin_amdgcn_mfma_f32_32x32x16_bf16(b0,qr[0],negm,0,0,0);p1=__builtin_amdgcn_mfma_f32_32x32x16_bf16(b1,qr[0],negm,0,0,0);}
    else{p0=__builtin_amdgcn_mfma_f32_32x32x16_bf16(b0,qr[d0],p0,0,0,0);p1=__builtin_amdgcn_mfma_f32_32x32x16_bf16(b1,qr[d0],p1,0,0,0);}}
}
typedef __attribute__((address_space(3))) const char* lds_cptr;
typedef short v4i16_t __attribute__((ext_vector_type(4)));
__device__ __forceinline__ void kload8(bf16x8*kf,lds_cptr kp){
  kf[0]=*(const __attribute__((address_space(3))) bf16x8*)(kp);      kf[1]=*(const __attribute__((address_space(3))) bf16x8*)(kp+512);
  kf[2]=*(const __attribute__((address_space(3))) bf16x8*)(kp+2048); kf[3]=*(const __attribute__((address_space(3))) bf16x8*)(kp+2560);
  kf[4]=*(const __attribute__((address_space(3))) bf16x8*)(kp+4096); kf[5]=*(const __attribute__((address_space(3))) bf16x8*)(kp+4608);
  kf[6]=*(const __attribute__((address_space(3))) bf16x8*)(kp+6144); kf[7]=*(const __attribute__((address_space(3))) bf16x8*)(kp+6656);
}
__device__ __forceinline__ void kload2(bf16x8*kf,lds_cptr kp,int j){ kf[2*j]=*(const __attribute__((address_space(3))) bf16x8*)(kp+j*2048); kf[2*j+1]=*(const __attribute__((address_space(3))) bf16x8*)(kp+j*2048+512); }
__device__ __forceinline__ s16x4 vtr(lds_cptr p){ return __builtin_bit_cast(s16x4,__builtin_amdgcn_ds_read_tr16_b64_v4i16((__attribute__((address_space(3))) v4i16_t*)p)); }
__device__ __forceinline__ float rowmax(const f32x16&p0,const f32x16&p1){
  float a=max3f(p0[0],p0[1],p1[0]),b=max3f(p0[2],p0[3],p1[1]);a=max3f(a,p1[2],p1[3]);
  #pragma unroll
  for(int r=4;r<16;r+=4){a=max3f(a,p0[r],p0[r+1]);b=max3f(b,p0[r+2],p0[r+3]);a=max3f(a,p1[r],p1[r+1]);b=max3f(b,p1[r+2],p1[r+3]);}
  const float m=max2f(a,b);
  auto rr=__builtin_amdgcn_permlane32_swap(__float_as_uint(m),__float_as_uint(m),false,false);
  return max2f(__uint_as_float(rr[0]),__uint_as_float(rr[1]));
}
__device__ __forceinline__ void pv(f32x16*o,int vb,bf16x8 pa0,bf16x8 pa1,bf16x8 pa2,bf16x8 pa3){
  #pragma unroll
  for(int d0=0;d0<2;++d0){s16x4 lo[4],hi[4];
    #pragma unroll
    for(int ks=0;ks<4;++ks){
      asm volatile("ds_read_b64_tr_b16 %0,%1 offset:%c2":"=&v"(lo[ks]):"v"(vb),"i"(d0*4096+ks*1024):"memory");
      asm volatile("ds_read_b64_tr_b16 %0,%1 offset:%c2":"=&v"(hi[ks]):"v"(vb),"i"(d0*4096+ks*1024+512):"memory");}
    asm volatile("s_waitcnt lgkmcnt(0)":::"memory");SBAR();
    #define PK(k) (bf16x8){lo[k][0],lo[k][1],lo[k][2],lo[k][3],hi[k][0],hi[k][1],hi[k][2],hi[k][3]}
    o[d0]=__builtin_amdgcn_mfma_f32_32x32x16_bf16(pa0,PK(0),o[d0],0,0,0);
    o[d0]=__builtin_amdgcn_mfma_f32_32x32x16_bf16(pa1,PK(1),o[d0],0,0,0);
    o[d0]=__builtin_amdgcn_mfma_f32_32x32x16_bf16(pa2,PK(2),o[d0],0,0,0);
    o[d0]=__builtin_amdgcn_mfma_f32_32x32x16_bf16(pa3,PK(3),o[d0],0,0,0);
    #undef PK
  }
}

#ifndef ATTN_STORE16
#define ATTN_STORE16(p,v) (*(u32x4*)(p)=(v))
#endif
template<int THRL> __device__ __forceinline__ void attn_unit(int b,int h,int qb,const bf16*Q,const bf16*__restrict__ K,const bf16*__restrict__ V,bf16*O,char*shm,const int wv){
  {
    typedef __attribute__((address_space(3))) float* lds_fptr;
    lds_fptr tb=(lds_fptr)((__attribute__((address_space(3))) char*)shm+LDS_CB); lds_fptr cl=(lds_fptr)((__attribute__((address_space(3))) char*)shm+LDS_CL);
    const float c0=cl[qb*QB];
    int t0_=wv*64+hw_lane(); asm volatile("":"+v"(t0_));
    _Pragma("unroll 1") for(int i=t0_;i<qb*QB+QB;i+=NW*64) tb[i]=(c0-cl[i])*1.4426950408889634f;
  }
  const int lane=hw_lane(),r32=lane&31,hi=lane>>5; const int wid=wv,tid=wid*64+lane; (void)tid;
  const long rowbase=(long)b*SEQ; const int q0=qb*QB;
  const bf16*Qw=Q+(rowbase+q0+wid*QBLK)*DM+h*D;
  const bf16*Kh=K+rowbase*DM+h*D,*Vh=V+rowbase*DM+h*D;
  const unsigned lds0=(unsigned)(uintptr_t)shm;
  float*wsf=(float*)(shm+LDS_WS)+wid*64;
  const bf16*ksrc=Kh+(long)lane*DM+wid*8;
  const bf16*vsrc=Vh+(long)(16*(wid&3)+(lane>>2))*DM+(wid>>2)*32+(lane&3)*8;
  const unsigned kdst=lds0+LDS_K+wid*1024, vdst=lds0+LDS_V+wid*1024;
  #define DMA_K(t,slot) glds16(ksrc+(long)(t)*KVBLK*DM,(unsigned)__builtin_amdgcn_readfirstlane(kdst+(slot)))
  #define DMA_V(t,slot) glds16(vsrc+(long)(t)*KVBLK*DM,(unsigned)__builtin_amdgcn_readfirstlane(vdst+(slot)))
  const int vb0=(int)(lds0+LDS_V)+((lane>>4)&1)*32+(lane&3)*8+(4*hi+((lane&15)>>2))*64;
  const char*Kbase=shm+LDS_K; bf16x8 kf[8];
  const lds_cptr shm3=(lds_cptr)shm; const lds_cptr kp0=shm3+LDS_K+hi*1024+r32*16; const lds_cptr vp0=shm3+LDS_V+((lane>>4)&1)*32+(lane&3)*8+(4*hi+((lane&15)>>2))*64;
  const int NT=(q0+QB)/KVBLK;
  DMA_K(0,0);DMA_V(0,0);DMA_K(1,SLOTB);
  bf16x8 qr[4];
  #pragma unroll
  for(int d0=0;d0<4;++d0)qr[d0]=*reinterpret_cast<const bf16x8*>(&Qw[(long)r32*DM+d0*16+hi*8]);
  float mhat=0.f,l_reg=0.f;f32x16 o[2];o[0]=f32x16{};o[1]=f32x16{};f32x16 negm=f32x16{};asm volatile("":"+v"(negm));
  const int qrel=wid*QBLK+r32;
  typedef float f32x4b __attribute__((ext_vector_type(4)));
  #define BIAS(P0,P1,t) do{ int hv_=hi; asm volatile("":"+v"(hv_)); const __attribute__((address_space(3))) f32x4b* cb4=(const __attribute__((address_space(3))) f32x4b*)(shm3+LDS_CB)+hv_; _Pragma("unroll") for(int j_=0;j_<4;++j_){ { const f32x4b a_=cb4[16*(t)+2*j_]; \
      P0[4*j_]+=a_[0];P0[4*j_+1]+=a_[1];P0[4*j_+2]+=a_[2];P0[4*j_+3]+=a_[3]; } SBAR(); { const f32x4b b_=cb4[16*(t)+2*j_+8]; P1[4*j_]+=b_[0];P1[4*j_+1]+=b_[1];P1[4*j_+2]+=b_[2];P1[4*j_+3]+=b_[3]; } SBAR(); } }while(0)
  #define CMASK(P0,P1,t) do{int jb_=(t)-(NT-4); if(jb_>=0){int q_=qrel,h_=hi; asm volatile("":"+v"(q_),"+v"(h_)); cmask(P0,P1,jb_,q_,h_);}}while(0)
  bool resc=false;
  #define START(P0,P1) do{ const float rm=rowmax(P0,P1); resc=false; \
    { const float dl=rm; mhat=fadd_s(mhat,dl); \
      _Pragma("unroll") for(int r=0;r<16;++r){P0[r]=fsub_s(P0[r],dl);P1[r]=fsub_s(P1[r],dl);} \
      _Pragma("unroll") for(int r=0;r<16;++r)negm[r]=-mhat; asm volatile("":"+v"(negm)); } \
    _Pragma("unroll") for(int r=0;r<16;++r)P0[r]=__builtin_amdgcn_exp2f(P0[r]); }while(0)
  #define RESC() do{ if(resc){ asm volatile("s_waitcnt lgkmcnt(0)":::"memory"); \
      _Pragma("unroll") for(int d_=0;d_<2;++d_) _Pragma("unroll") for(int r=0;r<16;++r)o[d_][r]*=wsf[crow(r,hi)]; } }while(0)
  f32x16 pA0,pA1,pB0,pB1;
  int sl_prev=0,sl_cur=0,sl_next=SLOTB;
  #define ROT() do{sl_prev=sl_cur;sl_cur=sl_next;sl_next=(sl_next==(NSLOT-1)*SLOTB)?0:sl_next+SLOTB;}while(0)
  DMA_K(2,2*SLOTB);
  WAIT_BAR(3);
  qkt(pA0,pA1,Kbase,qr,negm,r32,hi);asm volatile("s_nop 15\n\ts_nop 7":"+v"(pA0),"+v"(pA1));BIAS(pA0,pA1,0);CMASK(pA0,pA1,0);
  START(pA0,pA1);
  _Pragma("unroll") for(int r=0;r<16;++r)pA1[r]=__builtin_amdgcn_exp2f(pA1[r]);
  WAIT_BAR(0);
  DMA_K(3,0);DMA_V(1,SLOTB);
  ROT();
  kload8(kf,kp0+sl_cur);
  WAIT_BAR(2);
  s16x4 vlo[8],vhi[8]; u32x4 pw0,pw1,pw2,pw3;
  #define PKW(P,B) cvtpk_s(P[B],P[B+1])
  #define PAF(k) __builtin_bit_cast(bf16x8,pw##k)
  #define VFR(i) (bf16x8){vlo[i][0],vlo[i][1],vlo[i][2],vlo[i][3],vhi[i][0],vhi[i][1],vhi[i][2],vhi[i][3]}
  #define PIN(x) asm volatile("":"+v"(x))
  #define MX3(a,b,c) __builtin_fmaxf(__builtin_fmaxf((a),(b)),(c))
  #define GAPA(MF,A0,A1,A2,A3,W0,W1,PW) do{ MF; sacc+=A0; sacc+=A1; sacc+=A2; sacc+=A3; PIN(sacc); W0; W1; PIN(PW); SBAR(); }while(0)
  #define EX(v) __builtin_amdgcn_exp2f(v)
  #define GAPB(MF,X,B) do{ MF; X[B]=EX(X[B]); X[B+1]=EX(X[B+1]); X[B+2]=EX(X[B+2]); X[B+3]=EX(X[B+3]); PIN(X); SBAR(); }while(0)
  #define VRD(i) do{ vlo[i]=vtr(vp_+(((i)>>2)*4096+((i)&3)*1024)); vhi[i]=vtr(vp_+(((i)>>2)*4096+((i)&3)*1024+512)); }while(0)
  #define KRD(G,j) do{ if(G){ kload2(kf,kp0+sl_next,j); SBAR(); } }while(0)
  #define STEP(C0,C1,P0,P1,t,GK,GV,GL) do{ SBAR(); \
    const lds_cptr vp_=vp0+sl_prev; \
    VRD(0); SBAR(); float sacc=(P0[0]+P0[1]); \
    GAPA(C0=__builtin_amdgcn_mfma_f32_32x32x16_bf16(kf[0],qr[0],negm,0,0,0), P0[2],P0[3],P0[4],P0[5],     pw0[0]=PKW(P0,0), pw0[1]=PKW(P0,2), pw0); \
    VRD(4); SBAR(); GAPA(C1=__builtin_amdgcn_mfma_f32_32x32x16_bf16(kf[1],qr[0],negm,0,0,0), P0[6],P0[7],P0[8],P0[9],     pw0[2]=PKW(P0,4), pw0[3]=PKW(P0,6), pw0); \
    VRD(1); SBAR(); GAPA(C0=__builtin_amdgcn_mfma_f32_32x32x16_bf16(kf[2],qr[1],C0,0,0,0),   P0[10],P0[11],P0[12],P0[13], pw1[0]=PKW(P0,8), pw1[1]=PKW(P0,10), pw1); \
    VRD(5); SBAR(); GAPA(C1=__builtin_amdgcn_mfma_f32_32x32x16_bf16(kf[3],qr[1],C1,0,0,0),   P0[14],P0[15],P1[0],P1[1],   pw1[2]=PKW(P0,12),pw1[3]=PKW(P0,14), pw1); \
    VRD(2); SBAR(); GAPA(C0=__builtin_amdgcn_mfma_f32_32x32x16_bf16(kf[4],qr[2],C0,0,0,0),   P1[2],P1[3],P1[4],P1[5],     pw2[0]=PKW(P1,0), pw2[1]=PKW(P1,2), pw2); \
    VRD(6); SBAR(); GAPA(C1=__builtin_amdgcn_mfma_f32_32x32x16_bf16(kf[5],qr[2],C1,0,0,0),   P1[6],P1[7],P1[8],P1[9],     pw2[2]=PKW(P1,4), pw2[3]=PKW(P1,6), pw2); \
    VRD(3); SBAR(); GAPA(C0=__builtin_amdgcn_mfma_f32_32x32x16_bf16(kf[6],qr[3],C0,0,0,0),   P1[10],P1[11],P1[12],P1[13], pw3[0]=PKW(P1,8), pw3[1]=PKW(P1,10), pw3); \
    VRD(7); SBAR(); GAPA(C1=__builtin_amdgcn_mfma_f32_32x32x16_bf16(kf[7],qr[3],C1,0,0,0),   P1[14],P1[15],0.f,0.f,       pw3[2]=PKW(P1,12),pw3[3]=PKW(P1,14), pw3); \
    l_reg+=sacc; \
    if(GK){DMA_K((t)+3,sl_cur);} if(GV){DMA_V((t)+1,sl_next);} \
    BIAS(C0,C1,t); CMASK(C0,C1,t); \
    { float a=MX3(C0[0],C0[1],C1[0]),b=MX3(C0[2],C0[3],C1[1]); a=MX3(a,C1[2],C1[3]); \
      _Pragma("unroll") for(int r=4;r<16;r+=4){a=MX3(a,C0[r],C0[r+1]);b=MX3(b,C0[r+2],C0[r+3]);a=MX3(a,C1[r],C1[r+1]);b=MX3(b,C1[r+2],C1[r+3]);} \
      float rm=__builtin_fmaxf(a,b); { auto rr=__builtin_amdgcn_permlane32_swap(__float_as_uint(rm),__float_as_uint(rm),false,false); rm=__builtin_fmaxf(__uint_as_float(rr[0]),__uint_as_float(rr[1])); } \
      resc=false; \
      if(__builtin_expect(__any(rm>(float)THRL),0)){ const float dl=__builtin_fmaxf(rm,0.f); mhat+=dl; \
        _Pragma("unroll") for(int r=0;r<16;++r){C0[r]-=dl;C1[r]-=dl;} \
        _Pragma("unroll") for(int r=0;r<16;++r)negm[r]=-mhat; asm volatile("":"+v"(negm)); \
        const float f=__builtin_amdgcn_exp2f(-dl); l_reg*=f; if(hi==0)wsf[r32]=f; resc=true; } } \
    SBAR(); \
    GAPB(o[0]=__builtin_amdgcn_mfma_f32_32x32x16_bf16(PAF(0),VFR(0),o[0],0,0,0), C0,0); \
    GAPB(o[1]=__builtin_amdgcn_mfma_f32_32x32x16_bf16(PAF(0),VFR(4),o[1],0,0,0), C0,4); \
    KRD(GL,0); GAPB(o[0]=__builtin_amdgcn_mfma_f32_32x32x16_bf16(PAF(1),VFR(1),o[0],0,0,0), C0,8); \
    KRD(GL,1); GAPB(o[1]=__builtin_amdgcn_mfma_f32_32x32x16_bf16(PAF(1),VFR(5),o[1],0,0,0), C0,12); \
    KRD(GL,2); GAPB(o[0]=__builtin_amdgcn_mfma_f32_32x32x16_bf16(PAF(2),VFR(2),o[0],0,0,0), C1,0); \
    KRD(GL,3); GAPB(o[1]=__builtin_amdgcn_mfma_f32_32x32x16_bf16(PAF(2),VFR(6),o[1],0,0,0), C1,4); \
    GAPB(o[0]=__builtin_amdgcn_mfma_f32_32x32x16_bf16(PAF(3),VFR(3),o[0],0,0,0), C1,8); \
    GAPB(o[1]=__builtin_amdgcn_mfma_f32_32x32x16_bf16(PAF(3),VFR(7),o[1],0,0,0), C1,12); \
    }while(0)
  int t=1;
  #undef CMASK
  #define CMASK(P0,P1,t) do{}while(0)
  for(;t+5<NT;t+=2){
    STEP(pB0,pB1,pA0,pA1,t,true,true,true);     WAIT_BAR(2); RESC(); ROT();
    STEP(pA0,pA1,pB0,pB1,t+1,true,true,true);   WAIT_BAR(2); RESC(); ROT();
  }
  #undef CMASK
  #define CMASK(P0,P1,t) do{int jb_=(t)-(NT-4); if(jb_>=0){int q_=qrel,h_=hi; asm volatile("":"+v"(q_),"+v"(h_)); cmask(P0,P1,jb_,q_,h_);}}while(0)
  #define ENDW(tt) do{ if((tt)+3<NT){WAIT_BAR(2);} else if((tt)+2<NT){WAIT_BAR(1);} else {WAIT_BAR(0);} }while(0)
  for(;t+1<NT;t+=2){
    STEP(pB0,pB1,pA0,pA1,t,(t+3<NT),(t+1<NT),(t+1<NT));       ENDW(t);   RESC(); ROT();
    STEP(pA0,pA1,pB0,pB1,t+1,(t+4<NT),(t+2<NT),(t+2<NT));     ENDW(t+1); RESC(); ROT();
  }
  STEP(pB0,pB1,pA0,pA1,NT-1,false,false,false); RESC();
  { float sacc=pB0[0]+pB0[1]; _Pragma("unroll") for(int r=2;r<16;++r)sacc+=pB0[r]; _Pragma("unroll") for(int r=0;r<16;++r)sacc+=pB1[r]; l_reg+=sacc;
    pw0=(u32x4){PKW(pB0,0),PKW(pB0,2),PKW(pB0,4),PKW(pB0,6)};pw1=(u32x4){PKW(pB0,8),PKW(pB0,10),PKW(pB0,12),PKW(pB0,14)};pw2=(u32x4){PKW(pB1,0),PKW(pB1,2),PKW(pB1,4),PKW(pB1,6)};pw3=(u32x4){PKW(pB1,8),PKW(pB1,10),PKW(pB1,12),PKW(pB1,14)};
    SBAR(); pv(o,vb0+sl_cur,PAF(0),PAF(1),PAF(2),PAF(3)); }
  #undef PKW
  #undef PAF
  #undef VFR
  #undef PIN
  #undef MX3
  #undef GAPA
  #undef GAPB
  #undef EX
  #undef VRD
  #undef KRD
  #undef STEP
  #undef ENDW
  {auto rr=__builtin_amdgcn_permlane32_swap(__float_as_uint(l_reg),__float_as_uint(l_reg),false,false);l_reg=__uint_as_float(rr[0])+__uint_as_float(rr[1]);}
  if(hi==0)wsf[32+r32]=l_reg;asm volatile("s_waitcnt lgkmcnt(0)":::"memory");
  float rli[16];
  #pragma unroll
  for(int r=0;r<16;++r)rli[r]=__builtin_amdgcn_rcpf(wsf[32+crow(r,hi)]);
  bf16*Ow=O+(rowbase+q0+wid*QBLK)*ODM+h*D;
  { bf16*stg=(bf16*)(shm+LDS_OST)+wid*2048;
    #pragma unroll
    for(int r=0;r<16;++r){const int orow=crow(r,hi);
      #pragma unroll
      for(int d0=0;d0<2;++d0)stg[orow*64+d0*32+r32]=__float2bfloat16(o[d0][r]*rli[r]);}
    asm volatile("s_waitcnt lgkmcnt(0)":::"memory");
    #pragma unroll
    for(int i=0;i<4;++i){const int row=i*8+(lane>>3),ch=lane&7; const u32x4 v=*(const u32x4*)(stg+row*64+ch*8); ATTN_STORE16(Ow+(long)row*ODM+ch*8,v);} }
  asm volatile("s_waitcnt lgkmcnt(0)\n\ts_barrier":::"memory");
  #undef DMA_K
  #undef DMA_V
  #undef CMASK
  #undef START
  #undef RESC
  #undef BIAS
  #undef ROT
}
constexpr int ATTN_LDS_BYTES=LDS_BYTES;
struct AttnTensors { const bf16* Q; const bf16* K; const bf16* V; bf16* O; const float* LS; };
struct AttnUnit { int bh; int qb; };
struct StaticOrder {
  int G, blk;
  __device__ __forceinline__ explicit StaticOrder(int grid,int block):G(grid),blk(block){}
  __device__ __forceinline__ bool next(int i,AttnUnit&u)const{
    if(G==256){ if(i>=4)return false; const int v=(blk%8)*32+blk/8, e=v&1; u.bh=v>>1; u.qb=(i&1)?(8-i-e):(i+e); return true; }
    const int idx=i*G+blk; if(idx>=BATCH*NHEAD*NQB)return false; u.bh=idx/NQB; u.qb=NQB-1-(idx%NQB); return true; }
  __device__ __forceinline__ void a_ready(const AttnUnit&)const{}
  __device__ __forceinline__ void done(const AttnUnit&)const{}
};
template<class Sched,int THRL=8> __device__ __forceinline__ void attn_phase(char*lds,const AttnTensors&T,const Sched&S,const int wv){
  AttnUnit u; int cur_bh=-1;
  for(int i=0;S.next(i,u);++i){ S.a_ready(u);
    if(u.bh!=cur_bh){ cur_bh=u.bh;
      if(wv==0){ const int lane=hw_lane(); const float* p=T.LS+(long)u.bh*SEQ+32*lane; float v[32]; float run=0.f;
        _Pragma("unroll") for(int j=0;j<32;++j){ v[j]=__hip_atomic_load(p+j,__ATOMIC_RELAXED,__HIP_MEMORY_SCOPE_AGENT); }
        _Pragma("unroll") for(int j=0;j<32;++j){ run+=v[j]; v[j]=run; }
        float incl=run;
        _Pragma("unroll") for(int o=1;o<64;o<<=1){ const float t=__shfl_up(incl,o); if(lane>=o)incl+=t; }
        const float excl=incl-run;
        __attribute__((address_space(3))) float* cl=(__attribute__((address_space(3))) float*)((__attribute__((address_space(3))) char*)lds+LDS_CL)+32*lane;
        _Pragma("unroll") for(int j=0;j<32;++j) cl[j]=v[j]+excl; }
      asm volatile("s_waitcnt lgkmcnt(0)\n\ts_barrier":::"memory"); }
    attn_unit<THRL>(u.bh/NHEAD,u.bh%NHEAD,u.qb,T.Q,T.K,T.V,T.O,lds,wv); S.done(u); }
}
#undef SBAR
#undef WAIT_BAR
}

#define LAS __attribute__((address_space(3)))
typedef unsigned short bf16;
typedef float f32x4 __attribute__((ext_vector_type(4)));
typedef float f32x16 __attribute__((ext_vector_type(16)));
typedef unsigned u32x4 __attribute__((ext_vector_type(4)));
typedef unsigned u32x2 __attribute__((ext_vector_type(2)));
typedef short bf16x8 __attribute__((ext_vector_type(8)));
constexpr int NB = 16, SEQ = 2048, DM = 1024, T = NB * SEQ, NMEM = 256, TM = NB * NMEM;
constexpr int INC = 4104, DFF = 2816;
constexpr float EPS = 1e-6f, LOG2E = 1.4426950408889634f;
constexpr int NWAVES = 8, NTHR = 512;
constexpr int LDS_BYTES = 147456;
constexpr size_t MiB = 1u << 20;
constexpr size_t WS_W1 = 1 * MiB, WS_WPC = 9 * MiB, WS_WFO = 10 * MiB, WS_WOUT = 11 * MiB, WS_WXQ = 13 * MiB, WS_WXKV = 14 * MiB, WS_WXO = 16 * MiB,
                 WS_WFFI = 17 * MiB, WS_WFFO = 28 * MiB, WS_MEMB = 34 * MiB, WS_KX = 42 * MiB, WS_VXT = 46 * MiB, WS_LS = 50 * MiB, WS_C = 51 * MiB,
                 WS_SSQ0 = 52 * MiB, WS_SSQM = 52 * MiB + 256 * 1024, WS_SSQ1 = 53 * MiB, WS_SSQ2 = 55 * MiB, WS_SSQ3 = 57 * MiB,
                 WS_RA = 60 * MiB  , WS_RB = 124 * MiB  , WS_RC = 252 * MiB  , WS_RD = 348 * MiB  , WS_END = 380 * MiB;

__device__ __forceinline__ float bf2f(unsigned short b) { return __builtin_bit_cast(float, (unsigned)b << 16); }
__device__ __forceinline__ float bflo(unsigned w) { return __builtin_bit_cast(float, w << 16); }
__device__ __forceinline__ float bfhi(unsigned w) { return __builtin_bit_cast(float, w & 0xffff0000u); }
__device__ __forceinline__ unsigned pk2(float lo, float hi) { return pg8::cvt_pk_bf16(lo, hi); }
__device__ __forceinline__ float fsigmoid(float z) { return __builtin_amdgcn_rcpf(1.0f + __builtin_amdgcn_exp2f(-LOG2E * z)); }
__device__ __forceinline__ float rstd_of(float ssq) { return __builtin_amdgcn_rsqf(ssq * (1.0f / DM) + EPS); }
__device__ __forceinline__ float wave_sum(float v) {
#pragma unroll
    for (int o = 1; o < 64; o <<= 1) v += __shfl_xor(v, o);
    return v;
}
__device__ __forceinline__ float rstd_from_partials(const float* ssqp, int r, int fq) {
    const f32x4 p = *(const f32x4*)(ssqp + (size_t)r * 16 + 4 * fq);
    float s = (p[0] + p[1]) + (p[2] + p[3]);
    s += __shfl_xor(s, 16); s += __shfl_xor(s, 32);
    return rstd_of(s);
}

namespace epi {
using pg8::Unit;
constexpr float C2Q = 0.125f * LOG2E;
struct InProj {
    static constexpr bool PERM = true, AFTER_DRAIN = false, HAS_MID = false;
    bf16 *U, *Q, *K, *V, *G; const float* ssq0; const float* b_gate;
    __device__ __forceinline__ void operator()(const f32x4 (&acc)[2][2][4][2], const Unit& u, int wr, int wc, int fr, int fq) const {
        const int row0 = u.pm * 256 + wr * 64 + fr, ct = wc * 32 + 8 * fq, pn = u.pn;
        if (pn < 8) {
            const int sel = pn >> 1; bf16* base = sel == 0 ? U : sel == 1 ? Q : sel == 2 ? K : V; const float cs = sel == 1 ? C2Q : 1.0f;
            const int cc = (pn & 1) * 256 + ct;
#pragma unroll
            for (int ai = 0; ai < 2; ++ai)
#pragma unroll
                for (int m = 0; m < 4; ++m) { const int r = row0 + ai * 128 + m * 16; const float rs = rstd_of(ssq0[r]) * cs;
#pragma unroll
                    for (int bj = 0; bj < 2; ++bj) { const f32x4 v0 = acc[ai][bj][m][0] * rs, v1 = acc[ai][bj][m][1] * rs;
                        u32x4 w; w.x = pk2(v0[0], v0[1]); w.y = pk2(v0[2], v0[3]); w.z = pk2(v1[0], v1[1]); w.w = pk2(v1[2], v1[3]);
                        *(u32x4*)(base + (size_t)r * 512 + cc + bj * 128) = w; } }
        } else {
            const int gc = (pn - 8) * 256 + ct;
            f32x4 bv[2][2];
#pragma unroll
            for (int bj = 0; bj < 2; ++bj)
#pragma unroll
                for (int n = 0; n < 2; ++n) bv[bj][n] = *(const f32x4*)(b_gate + gc + bj * 128 + 4 * n);
#pragma unroll
            for (int ai = 0; ai < 2; ++ai)
#pragma unroll
                for (int m = 0; m < 4; ++m) { const int r = row0 + ai * 128 + m * 16; const float rs = rstd_of(ssq0[r]);
#pragma unroll
                    for (int bj = 0; bj < 2; ++bj) { const f32x4 z0 = acc[ai][bj][m][0] * rs + bv[bj][0], z1 = acc[ai][bj][m][1] * rs + bv[bj][1];
                        u32x4 w; w.x = pk2(fsigmoid(z0[0]), fsigmoid(z0[1])); w.y = pk2(fsigmoid(z0[2]), fsigmoid(z0[3])); w.z = pk2(fsigmoid(z1[0]), fsigmoid(z1[1])); w.w = pk2(fsigmoid(z1[2]), fsigmoid(z1[3]));
                        *(u32x4*)(G + (size_t)r * 2048 + gc + bj * 128) = w; } }
        }
    }
};
struct MemKV {
    static constexpr bool PERM = true, AFTER_DRAIN = false, HAS_MID = false;
    bf16 *KX, *VXT; const float* ssqm;
    __device__ __forceinline__ void operator()(const f32x4 (&acc)[2][2][4][2], const Unit& u, int wr, int wc, int fr, int fq) const {
        const int row0 = u.pm * 256 + wr * 64 + fr, ct = wc * 32 + 8 * fq, pn = u.pn;
#pragma unroll
        for (int ai = 0; ai < 2; ++ai)
#pragma unroll
            for (int m = 0; m < 4; ++m) { const int r = row0 + ai * 128 + m * 16; const float rs = rstd_of(ssqm[r]);
#pragma unroll
                for (int bj = 0; bj < 2; ++bj) { const f32x4 v0 = acc[ai][bj][m][0] * rs, v1 = acc[ai][bj][m][1] * rs;
                    if (pn < 2) { u32x4 w; w.x = pk2(v0[0], v0[1]); w.y = pk2(v0[2], v0[3]); w.z = pk2(v1[0], v1[1]); w.w = pk2(v1[2], v1[3]);
                        *(u32x4*)(KX + (size_t)r * 512 + pn * 256 + bj * 128 + ct) = w; }
                    else { const int b = r >> 8, mk = r & 255, pos = (mk & ~12) | ((mk & 4) << 1) | ((mk & 8) >> 1); const int c0 = (pn - 2) * 256 + bj * 128 + ct;
                        bf16* vp = VXT + ((size_t)b * 512 + c0) * 256 + pos;
                        const unsigned w0 = pk2(v0[0], v0[1]), w1 = pk2(v0[2], v0[3]), w2 = pk2(v1[0], v1[1]), w3 = pk2(v1[2], v1[3]);
                        vp[0 * 256] = (bf16)w0; vp[1 * 256] = (bf16)(w0 >> 16); vp[2 * 256] = (bf16)w1; vp[3 * 256] = (bf16)(w1 >> 16);
                        vp[4 * 256] = (bf16)w2; vp[5 * 256] = (bf16)(w2 >> 16); vp[6 * 256] = (bf16)w3; vp[7 * 256] = (bf16)(w3 >> 16); } } }
    }
};
struct Mix {
    static constexpr bool PERM = true, AFTER_DRAIN = false, HAS_MID = true;
    const bf16* G; bf16* Z;
    __device__ __forceinline__ void mid(f32x4 (&acc)[2][2][4][2], const Unit& u, int wr, int wc, int fr, int fq) const {
        const bf16* gb = G + (size_t)(u.pm * 256 + wr * 64 + fr) * 2048 + u.pn * 256 + wc * 32 + 8 * fq;
#pragma unroll
        for (int ai = 0; ai < 2; ++ai) { asm volatile("" : "+v"(gb));
            u32x4 gp[4][2], gf[4][2];
#pragma unroll
            for (int m = 0; m < 4; ++m)
#pragma unroll
                for (int bj = 0; bj < 2; ++bj) { const bf16* gr = gb + (size_t)(ai * 128 + m * 16) * 2048 + bj * 128; gp[m][bj] = *(const u32x4*)gr; gf[m][bj] = *(const u32x4*)(gr + 1024); }
#pragma unroll
            for (int m = 0; m < 4; ++m)
#pragma unroll
                for (int bj = 0; bj < 2; ++bj) { const u32x4 p = gp[m][bj], f = gf[m][bj];
                    acc[ai][bj][m][0][0] *= bflo(p.x) * __builtin_amdgcn_rcpf(bflo(f.x)); acc[ai][bj][m][0][1] *= bfhi(p.x) * __builtin_amdgcn_rcpf(bfhi(f.x));
                    acc[ai][bj][m][0][2] *= bflo(p.y) * __builtin_amdgcn_rcpf(bflo(f.y)); acc[ai][bj][m][0][3] *= bfhi(p.y) * __builtin_amdgcn_rcpf(bfhi(f.y));
                    acc[ai][bj][m][1][0] *= bflo(p.z) * __builtin_amdgcn_rcpf(bflo(f.z)); acc[ai][bj][m][1][1] *= bfhi(p.z) * __builtin_amdgcn_rcpf(bfhi(f.z));
                    acc[ai][bj][m][1][2] *= bflo(p.w) * __builtin_amdgcn_rcpf(bflo(f.w)); acc[ai][bj][m][1][3] *= bfhi(p.w) * __builtin_amdgcn_rcpf(bfhi(f.w)); }
            __builtin_amdgcn_sched_barrier(0); }
    }
    __device__ __forceinline__ void operator()(const f32x4 (&acc)[2][2][4][2], const Unit& u, int wr, int wc, int fr, int fq) const {
        const int row0 = u.pm * 256 + wr * 64 + fr, c0 = u.pn * 256 + wc * 32 + 8 * fq;
#pragma unroll
        for (int ai = 0; ai < 2; ++ai) { u32x4 gf[4][2];
#pragma unroll
            for (int m = 0; m < 4; ++m)
#pragma unroll
                for (int bj = 0; bj < 2; ++bj) gf[m][bj] = *(const u32x4*)(G + (size_t)(row0 + ai * 128 + m * 16) * 2048 + 1024 + c0 + bj * 128);
#pragma unroll
            for (int m = 0; m < 4; ++m) { const int r = row0 + ai * 128 + m * 16;
#pragma unroll
                for (int bj = 0; bj < 2; ++bj) { const u32x4 f = gf[m][bj]; const f32x4 a0 = acc[ai][bj][m][0], a1 = acc[ai][bj][m][1];
                    u32x4 w; w.x = pk2(a0[0] * bflo(f.x), a0[1] * bfhi(f.x)); w.y = pk2(a0[2] * bflo(f.y), a0[3] * bfhi(f.y)); w.z = pk2(a1[0] * bflo(f.z), a1[1] * bfhi(f.z)); w.w = pk2(a1[2] * bflo(f.w), a1[3] * bfhi(f.w));
                    *(u32x4*)(Z + (size_t)r * 1024 + c0 + bj * 128) = w; } }
            asm volatile("" ::: "memory"); }
    }
};
template <bool BF> struct Resid {
    static constexpr bool PERM = true, AFTER_DRAIN = false, HAS_MID = false;
    const void* base; bf16* outb; float* ssqp;
    __device__ __forceinline__ void operator()(const f32x4 (&acc)[2][2][4][2], const Unit& u, int wr, int wc, int fr, int fq) const {
        const int row0 = u.pm * 256 + wr * 64 + fr, c0 = u.pn * 256 + wc * 32 + 8 * fq;
        constexpr int MB = 4;
#pragma unroll
        for (int ai = 0; ai < 2; ++ai)
#pragma unroll
            for (int m0 = 0; m0 < 4; m0 += MB) {
                f32x4 b0[MB][2], b1[MB][2]; u32x4 qq[MB][2];
#pragma unroll
                for (int mm = 0; mm < MB; ++mm)
#pragma unroll
                    for (int bj = 0; bj < 2; ++bj) { const size_t off = (size_t)(row0 + ai * 128 + (m0 + mm) * 16) * 1024 + c0 + bj * 128;
                        if (BF) qq[mm][bj] = *(const u32x4*)((const bf16*)base + off);
                        else { b0[mm][bj] = *(const f32x4*)((const float*)base + off); b1[mm][bj] = *(const f32x4*)((const float*)base + off + 4); } }
#pragma unroll
                for (int mm = 0; mm < MB; ++mm) { const int m = m0 + mm, r = row0 + ai * 128 + m * 16; float s = 0.f;
#pragma unroll
                    for (int bj = 0; bj < 2; ++bj) { const size_t off = (size_t)r * 1024 + c0 + bj * 128; f32x4 x0, x1;
                        if (BF) { const u32x4 q = qq[mm][bj]; x0 = (f32x4){bflo(q.x), bfhi(q.x), bflo(q.y), bfhi(q.y)}; x1 = (f32x4){bflo(q.z), bfhi(q.z), bflo(q.w), bfhi(q.w)}; }
                        else { x0 = b0[mm][bj]; x1 = b1[mm][bj]; }
                        const f32x4 v0 = x0 + acc[ai][bj][m][0], v1 = x1 + acc[ai][bj][m][1];
                        u32x4 w; w.x = pk2(v0[0], v0[1]); w.y = pk2(v0[2], v0[3]); w.z = pk2(v1[0], v1[1]); w.w = pk2(v1[2], v1[3]); *(u32x4*)(outb + off) = w;
                        const float r0 = bflo(w.x), r1 = bfhi(w.x), r2 = bflo(w.y), r3 = bfhi(w.y), r4 = bflo(w.z), r5 = bfhi(w.z), r6 = bflo(w.w), r7 = bfhi(w.w);
                        s += (r0 * r0 + r1 * r1) + (r2 * r2 + r3 * r3) + (r4 * r4 + r5 * r5) + (r6 * r6 + r7 * r7); }
                    s += __shfl_xor(s, 16); s += __shfl_xor(s, 32);
                    if (fq == 0) ssqp[(size_t)r * 16 + u.pn * 4 + wc] = s; }
                asm volatile("" ::: "memory"); }
    }
};
struct ScaleRow {
    static constexpr bool PERM = true, AFTER_DRAIN = false, HAS_MID = false;
    bf16* O; int ldc; const float* ssqp;
    __device__ __forceinline__ void operator()(const f32x4 (&acc)[2][2][4][2], const Unit& u, int wr, int wc, int fr, int fq) const {
        const int row0 = u.pm * 256 + wr * 64 + fr, c0 = u.pn * 256 + wc * 32 + 8 * fq;
        f32x4 pp[2][4];
#pragma unroll
        for (int ai = 0; ai < 2; ++ai)
#pragma unroll
            for (int m = 0; m < 4; ++m) pp[ai][m] = *(const f32x4*)(ssqp + (size_t)(row0 + ai * 128 + m * 16) * 16 + 4 * fq);
#pragma unroll
        for (int ai = 0; ai < 2; ++ai)
#pragma unroll
            for (int m = 0; m < 4; ++m) { const int r = row0 + ai * 128 + m * 16; float s = (pp[ai][m][0] + pp[ai][m][1]) + (pp[ai][m][2] + pp[ai][m][3]); s += __shfl_xor(s, 16); s += __shfl_xor(s, 32); const float rs = rstd_of(s);
#pragma unroll
                for (int bj = 0; bj < 2; ++bj) { const f32x4 v0 = acc[ai][bj][m][0] * rs, v1 = acc[ai][bj][m][1] * rs;
                    u32x4 w; w.x = pk2(v0[0], v0[1]); w.y = pk2(v0[2], v0[3]); w.z = pk2(v1[0], v1[1]); w.w = pk2(v1[2], v1[3]);
                    *(u32x4*)(O + (size_t)r * ldc + c0 + bj * 128) = w; } }
    }
};
struct SwiGLU {
    static constexpr bool PERM = true, AFTER_DRAIN = false, HAS_MID = false;
    bf16* ACT; const float* ssqp;
    __device__ __forceinline__ void operator()(const f32x4 (&acc)[2][2][4][2], const Unit& u, int wr, int wc, int fr, int fq) const {
        const int row0 = u.pm * 256 + wr * 64 + fr, c0 = u.pn * 128 + wc * 32 + 8 * fq;
        f32x4 pp[2][4];
#pragma unroll
        for (int ai = 0; ai < 2; ++ai)
#pragma unroll
            for (int m = 0; m < 4; ++m) pp[ai][m] = *(const f32x4*)(ssqp + (size_t)(row0 + ai * 128 + m * 16) * 16 + 4 * fq);
#pragma unroll
        for (int ai = 0; ai < 2; ++ai)
#pragma unroll
            for (int m = 0; m < 4; ++m) { const int r = row0 + ai * 128 + m * 16; float s = (pp[ai][m][0] + pp[ai][m][1]) + (pp[ai][m][2] + pp[ai][m][3]); s += __shfl_xor(s, 16); s += __shfl_xor(s, 32); const float rs = rstd_of(s);
                float h[8];
#pragma unroll
                for (int n = 0; n < 2; ++n)
#pragma unroll
                    for (int j = 0; j < 4; ++j) { const float g = acc[ai][0][m][n][j] * rs, up = acc[ai][1][m][n][j] * rs; h[4 * n + j] = g * fsigmoid(g) * up; }
                u32x4 w; w.x = pk2(h[0], h[1]); w.y = pk2(h[2], h[3]); w.z = pk2(h[4], h[5]); w.w = pk2(h[6], h[7]);
                *(u32x4*)(ACT + (size_t)r * DFF + c0) = w; }
    }
};
}

__device__ __forceinline__ void tr_item(const float* W, int ldw, int K, int k0, int sc0, bf16* WT, int dr0, const float* gain, float cs, LAS float* scr, int lane) {
#pragma unroll 16
    for (int i = 0; i < 32; ++i) { const int kk = 2 * i + (lane >> 5); const float g = gain ? gain[k0 + kk] * cs : cs;
        scr[kk * 33 + (lane & 31)] = W[(size_t)(k0 + kk) * ldw + sc0 + (lane & 31)] * g; }
    asm volatile("s_waitcnt lgkmcnt(0)" ::: "memory");
    const int c = lane & 7;
#pragma unroll
    for (int j = 0; j < 4; ++j) { const int n = (lane >> 3) + 8 * j; const LAS float* s = scr + (8 * c) * 33 + n;
        u32x4 o; o.x = pk2(s[0 * 33], s[1 * 33]); o.y = pk2(s[2 * 33], s[3 * 33]); o.z = pk2(s[4 * 33], s[5 * 33]); o.w = pk2(s[6 * 33], s[7 * 33]);
        *(u32x4*)(WT + (size_t)(dr0 + n) * K + k0 + 8 * c) = o; }
    asm volatile("s_waitcnt lgkmcnt(0)" ::: "memory");
}

struct Args { const float* in[20]; float* out; unsigned char* ws; };

__device__ __forceinline__ void xattn_unit(int tb, int h, const bf16* QX, const bf16* KX, const bf16* VXT, bf16* OX, int wid, int lane, LAS unsigned char* ldsl) {
    const int r32 = lane & 31, hi = lane >> 5, b = tb >> 3, tid = wid * 64 + lane;
    const size_t qrow = (size_t)tb * 256 + wid * 32 + r32;
    bf16x8 qr[8];
#pragma unroll
    for (int d0 = 0; d0 < 8; ++d0) qr[d0] = *(const bf16x8*)(QX + qrow * 512 + h * 128 + d0 * 16 + hi * 8);
    {
        u32x4 kt[8], vt[8];
#pragma unroll
        for (int i = 0; i < 8; ++i) { const int idx = tid + i * NTHR, key = idx >> 4, c = idx & 15; kt[i] = *(const u32x4*)(KX + ((size_t)b * 256 + key) * 512 + h * 128 + c * 8); }
#pragma unroll
        for (int i = 0; i < 8; ++i) { const int idx = tid + i * NTHR, d = idx >> 5, q = idx & 31; vt[i] = *(const u32x4*)(VXT + ((size_t)(b * 4 + h) * 128 + d) * 256 + q * 8); }
#pragma unroll
        for (int i = 0; i < 8; ++i) { const int idx = tid + i * NTHR, key = idx >> 4, c = idx & 15; *(LAS u32x4*)(ldsl + ((((key >> 5) * 16 + c) * 32 + (key & 31)) * 16)) = kt[i]; }
#pragma unroll
        for (int i = 0; i < 8; ++i) { const int idx = tid + i * NTHR, d = idx >> 5, q = idx & 31; *(LAS u32x4*)(ldsl + 65536 + (((((q >> 2) * 4 + (d >> 5)) * 4 + (q & 3)) * 32 + (d & 31)) * 16)) = vt[i]; }
    }
    __syncthreads();
    f32x16 o[4];
#pragma unroll
    for (int i = 0; i < 4; ++i) o[i] = f32x16{};
    float mrow = -1e30f, l = 0.f;
    const LAS unsigned char* kl = ldsl + (hi * 32 + r32) * 16;
    const LAS unsigned char* vl = ldsl + 65536 + (hi * 32 + r32) * 16;
#pragma unroll 1
    for (int kb = 0; kb < 8; ++kb) {
        f32x16 st = f32x16{};
#pragma unroll
        for (int d0 = 0; d0 < 8; ++d0) { const bf16x8 kf = *(const LAS bf16x8*)(kl + (kb * 16 + d0 * 2) * 512); st = __builtin_amdgcn_mfma_f32_32x32x16_bf16(kf, qr[d0], st, 0, 0, 0); }
        float mx = st[0];
#pragma unroll
        for (int r = 1; r < 16; ++r) mx = fmaxf(mx, st[r]);
        mx = fmaxf(mx, __shfl_xor(mx, 32));
        const float mn = fmaxf(mrow, mx), corr = __builtin_amdgcn_exp2f(mrow - mn); mrow = mn;
        float ps = 0.f;
#pragma unroll
        for (int r = 0; r < 16; ++r) { st[r] = __builtin_amdgcn_exp2f(st[r] - mn); ps += st[r]; }
        l = l * corr + ps;
#pragma unroll
        for (int db = 0; db < 4; ++db)
#pragma unroll
            for (int r = 0; r < 16; ++r) o[db][r] *= corr;
        u32x4 p0, p1;
        p0.x = pk2(st[0], st[1]); p0.y = pk2(st[2], st[3]); p0.z = pk2(st[4], st[5]); p0.w = pk2(st[6], st[7]);
        p1.x = pk2(st[8], st[9]); p1.y = pk2(st[10], st[11]); p1.z = pk2(st[12], st[13]); p1.w = pk2(st[14], st[15]);
        const bf16x8 pa0 = __builtin_bit_cast(bf16x8, p0), pa1 = __builtin_bit_cast(bf16x8, p1);
#pragma unroll
        for (int db = 0; db < 4; ++db) { const bf16x8 v0 = *(const LAS bf16x8*)(vl + ((kb * 4 + db) * 4) * 512), v1 = *(const LAS bf16x8*)(vl + ((kb * 4 + db) * 4 + 2) * 512);
            o[db] = __builtin_amdgcn_mfma_f32_32x32x16_bf16(v0, pa0, o[db], 0, 0, 0); o[db] = __builtin_amdgcn_mfma_f32_32x32x16_bf16(v1, pa1, o[db], 0, 0, 0); }
    }
    l += __shfl_xor(l, 32);
    const float inv = 1.0f / l;
    bf16* orow = OX + qrow * 512 + h * 128 + 4 * hi;
#pragma unroll
    for (int db = 0; db < 4; ++db)
#pragma unroll
        for (int jj = 0; jj < 4; ++jj) { u32x2 w; w.x = pk2(o[db][4 * jj] * inv, o[db][4 * jj + 1] * inv); w.y = pk2(o[db][4 * jj + 2] * inv, o[db][4 * jj + 3] * inv);
            *(u32x2*)(orow + db * 32 + 8 * jj) = w; }
    __syncthreads();
}

__device__ __forceinline__ void grid_bar(unsigned* ctr, unsigned target, bool leader) {
    asm volatile("s_waitcnt vmcnt(0) lgkmcnt(0)" ::: "memory");
    __syncthreads();
    if (leader) {
        __builtin_amdgcn_fence(__ATOMIC_RELEASE, "agent");
        asm volatile("s_waitcnt vmcnt(0)" ::: "memory");
        __hip_atomic_fetch_add(ctr, 1u, __ATOMIC_RELAXED, __HIP_MEMORY_SCOPE_AGENT);
        while (__hip_atomic_load(ctr, __ATOMIC_RELAXED, __HIP_MEMORY_SCOPE_AGENT) < target) __builtin_amdgcn_s_sleep(2);
        __builtin_amdgcn_fence(__ATOMIC_ACQUIRE, "agent");
        asm volatile("s_waitcnt vmcnt(0)" ::: "memory");
    }
    __syncthreads();
}
__device__ __forceinline__ void xcd_local_bar(unsigned* ctr, unsigned target, bool leader) {
    asm volatile("s_waitcnt vmcnt(0) lgkmcnt(0)" ::: "memory");
    __syncthreads();
    if (leader) {
        __hip_atomic_fetch_add(ctr, 1u, __ATOMIC_RELAXED, __HIP_MEMORY_SCOPE_AGENT);
        while (__hip_atomic_load(ctr, __ATOMIC_RELAXED, __HIP_MEMORY_SCOPE_AGENT) < target) __builtin_amdgcn_s_sleep(1);
        __builtin_amdgcn_fence(__ATOMIC_ACQUIRE, "agent");
        asm volatile("s_waitcnt vmcnt(0)" ::: "memory");
    }
    __syncthreads();
}
#ifndef REP_P0
#define REP_P0 1
#endif
#ifndef REP_P1
#define REP_P1 1
#endif
#ifndef REP_P2
#define REP_P2 1
#endif
#ifndef REP_P3
#define REP_P3 1
#endif
#ifndef REP_P4
#define REP_P4 1
#endif
#ifndef REP_P5A
#define REP_P5A 1
#endif
#ifndef REP_P5B
#define REP_P5B 1
#endif
#ifndef REP_P5C
#define REP_P5C 1
#endif
#ifndef REP_P6
#define REP_P6 1
#endif
#ifndef REP_P7
#define REP_P7 1
#endif
#ifndef REP_P8
#define REP_P8 1
#endif
#ifndef REP_P0T
#define REP_P0T 1
#endif
#ifndef REP_P0F
#define REP_P0F 1
#endif
#ifndef REP_P0R
#define REP_P0R 1
#endif
#ifndef REP_P1B
#define REP_P1B 1
#endif
__device__ __forceinline__ int opq(int k) { asm volatile("" : "+s"(k)); return k; }
typedef __attribute__((address_space(1))) unsigned char* gptr_t;
__device__ __forceinline__ gptr_t opq_ptr(const void* p) { gptr_t g = (gptr_t)p; asm volatile("" : "+s"(g)); return g; }
#define DECL_PTRS \
    gptr_t ws = opq_ptr(args.ws); \
    const int Gq = opq(G), bq = opq(blk), gw = bq * NWAVES + wave, NGW = Gq * NWAVES, hb = (Gq % 8 == 0) ? (bq % 8) * (Gq / 8) + bq / 8 : bq; (void)gw; (void)NGW; (void)hb; \
    const float* x = (const float*)opq_ptr(args.in[opq(0)]); const float* mem = (const float*)opq_ptr(args.in[opq(1)]); const float* norm_mix_g = (const float*)opq_ptr(args.in[opq(2)]); const float* w_in = (const float*)opq_ptr(args.in[opq(3)]); \
    const float* b_forget = (const float*)opq_ptr(args.in[opq(4)]); const float* b_gate = (const float*)opq_ptr(args.in[opq(5)]); const float* pool_w = (const float*)opq_ptr(args.in[opq(6)]); const float* pool_scale = (const float*)opq_ptr(args.in[opq(7)]); \
    const float* w_pool_out = (const float*)opq_ptr(args.in[opq(8)]); const float* w_fox_out = (const float*)opq_ptr(args.in[opq(9)]); const float* w_out = (const float*)opq_ptr(args.in[opq(10)]); const float* norm_x_g = (const float*)opq_ptr(args.in[opq(11)]); \
    const float* norm_mem_g = (const float*)opq_ptr(args.in[opq(12)]); const float* w_xq = (const float*)opq_ptr(args.in[opq(13)]); const float* w_xkv = (const float*)opq_ptr(args.in[opq(14)]); const float* w_xo = (const float*)opq_ptr(args.in[opq(15)]); \
    const float* norm_ffn_g = (const float*)opq_ptr(args.in[opq(16)]); const float* w_ffn_in = (const float*)opq_ptr(args.in[opq(17)]); const float* w_ffn_out = (const float*)opq_ptr(args.in[opq(18)]); const float* norm_final_g = (const float*)opq_ptr(args.in[opq(19)]); \
    float* out = (float*)opq_ptr(args.out); \
    bf16 *W1t = (bf16*)(ws + WS_W1), *Wmix = (bf16*)(ws + WS_WPC) , *Wout = (bf16*)(ws + WS_WOUT), *Wxq = (bf16*)(ws + WS_WXQ), *Wxkv = (bf16*)(ws + WS_WXKV), \
         *Wxo = (bf16*)(ws + WS_WXO), *Wffi = (bf16*)(ws + WS_WFFI), *Wffo = (bf16*)(ws + WS_WFFO), *MEMB = (bf16*)(ws + WS_MEMB), *KX = (bf16*)(ws + WS_KX), *VXT = (bf16*)(ws + WS_VXT); \
    float *LS = (float*)(ws + WS_LS), *CC = (float*)(ws + WS_C), *SSQ0 = (float*)(ws + WS_SSQ0), *SSQM = (float*)(ws + WS_SSQM), *SSQ1 = (float*)(ws + WS_SSQ1), *SSQ2 = (float*)(ws + WS_SSQ2), *SSQ3 = (float*)(ws + WS_SSQ3); \
    bf16 *XB = (bf16*)(ws + WS_RA), *AD = (bf16*)(ws + WS_RA), *X1B = (bf16*)(ws + WS_RA), *X2B = (bf16*)(ws + WS_RA); \
    bf16 *GT = (bf16*)(ws + WS_RB), *QX = (bf16*)(ws + WS_RB), *OX = (bf16*)(ws + WS_RB + 32 * MiB), *ACT = (bf16*)(ws + WS_RB); \
    bf16 *QF = (bf16*)(ws + WS_RC), *KF = (bf16*)(ws + WS_RC + 32 * MiB), *VF = (bf16*)(ws + WS_RC + 64 * MiB), *ZB = (bf16*)(ws + WS_RC); \
    bf16 *UB = (bf16*)(ws + WS_RD);
__global__ void __launch_bounds__(NTHR, 2) hybrid_fwd(Args args) {
    extern __shared__ __attribute__((aligned(16))) unsigned char lds[];
    cg::grid_group grid = cg::this_grid();
    LAS unsigned char* ldsl = (LAS unsigned char*)lds;
    const int wave = __builtin_amdgcn_readfirstlane((int)threadIdx.x >> 6);
    grid.sync();
    const int G = gridDim.x, blk = blockIdx.x;
    unsigned bar_target = 0;
#define GRID_BAR() do { bar_target += (unsigned)G; grid_bar((unsigned*)opq_ptr(args.ws), bar_target, wave == 0 && hw_lane() == 0); } while (0)
    unsigned xbar_target = 0;
    int use_xcd = 0;
    if (wave == 0 && hw_lane() == 0) __hip_atomic_store((unsigned*)opq_ptr(args.ws) + 2048 + blk, (unsigned)__builtin_amdgcn_s_getreg((3 << 11) | 20) & 0xFu, __ATOMIC_RELAXED, __HIP_MEMORY_SCOPE_AGENT);
#define XCD_BAR() do { if (use_xcd) { xbar_target += (unsigned)(G / 8); xcd_local_bar((unsigned*)opq_ptr(args.ws) + 64 * (1 + (blk & 7)), xbar_target, wave == 0 && hw_lane() == 0); } else GRID_BAR(); } while (0)
#ifndef SKIP_P0
    for (int rep_ = 0; rep_ < REP_P0; ++rep_) {
    DECL_PTRS
    (void)x; (void)mem; (void)out; (void)CC;
    {
        const int lane = hw_lane(), tid = wave * 64 + lane;
        LAS float* scr = (LAS float*)(ldsl + wave * 16384);
        constexpr int I0 = 16 * 128, I1 = 8 * 32, I2 = 16 * 32, I3 = 16 * 16, I4 = 16 * 32, I5 = 8 * 32, I6 = 16 * 176, I7 = 44 * 32;
        constexpr int NIT = I0 + I1 + I2 + I3 + I4 + I5 + I6 + I7;
        for (int rt_ = 0; rt_ < REP_P0T; ++rt_)
        for (int it = gw; it < NIT; it += NGW) {
            int r = it;
            if (r < I0) { const int kb = r / 128, nb = r % 128, n0 = 32 * nb; tr_item(w_in, INC, 1024, 64 * kb, n0 < 2048 ? n0 : n0 + 8, W1t, n0, norm_mix_g, 1.0f, scr, lane); continue; } r -= I0;
            if (r < I1) { const int kb = r / 32, nb = r % 32; tr_item(w_fox_out, 1024, 1024, 64 * kb, 32 * nb, Wmix + 512, 32 * nb, nullptr, 1.0f, scr, lane); continue; } r -= I1;
            if (r < I2) { const int kb = r / 32, nb = r % 32; tr_item(w_out, 1024, 1024, 64 * kb, 32 * nb, Wout, 32 * nb, nullptr, 1.0f, scr, lane); continue; } r -= I2;
            if (r < I3) { const int kb = r / 16, nb = r % 16; tr_item(w_xq, 512, 1024, 64 * kb, 32 * nb, Wxq, 32 * nb, norm_x_g, 0.08838834764831845f * LOG2E, scr, lane); continue; } r -= I3;
            if (r < I4) { const int kb = r / 32, nb = r % 32; tr_item(w_xkv, 1024, 1024, 64 * kb, 32 * nb, Wxkv, 32 * nb, norm_mem_g, 1.0f, scr, lane); continue; } r -= I4;
            if (r < I5) { const int kb = r / 32, nb = r % 32; tr_item(w_xo, 1024, 512, 64 * kb, 32 * nb, Wxo, 32 * nb, nullptr, 1.0f, scr, lane); continue; } r -= I5;
            if (r < I6) { const int kb = r / 176, nb = r % 176, n0 = 32 * nb, j = n0 >> 8, wi = n0 & 255; const int sc = wi < 128 ? 128 * j + wi : DFF + 128 * j + (wi - 128);
                          tr_item(w_ffn_in, 2 * DFF, 1024, 64 * kb, sc, Wffi, n0, norm_ffn_g, 1.0f, scr, lane); continue; } r -= I6;
            { const int kb = r / 32, nb = r % 32; tr_item(w_ffn_out, 1024, DFF, 64 * kb, 32 * nb, Wffo, 32 * nb, nullptr, 1.0f, scr, lane); }
        }
        for (int rf_ = 0; rf_ < REP_P0F; ++rf_)
        for (int bi = blk; bi < 128; bi += G) { const int nb = bi >> 3, kl = bi & 7, k0 = kl * 64 + wave * 8, gb = (k0 >> 7) * 128, n = nb * 64 + lane;
            float a[8];
#pragma unroll
            for (int kk = 0; kk < 8; ++kk) a[kk] = 0.f;
#pragma unroll 8
            for (int d = 0; d < 128; ++d) { const float wv = w_pool_out[(size_t)(gb + d) * 1024 + n] * pool_scale[gb + d];
#pragma unroll
                for (int kk = 0; kk < 8; ++kk) a[kk] += pool_w[(size_t)(k0 + kk) * 128 + d] * wv; }
            u32x4 o; o.x = pk2(a[0], a[1]); o.y = pk2(a[2], a[3]); o.z = pk2(a[4], a[5]); o.w = pk2(a[6], a[7]);
            *(u32x4*)(Wmix + (size_t)n * 1024 + k0) = o; }
        __syncthreads();
        LAS float* gwt = (LAS float*)ldsl;
#pragma unroll
        for (int i = 0; i < 16; ++i) { const int idx = tid + i * NTHR, h = idx & 7, k = idx >> 3; gwt[h * 1024 + k] = norm_mix_g[k] * w_in[(size_t)k * INC + 2048 + h]; }
        __syncthreads();
        const int rpb = (T + G - 1) / G, rpw = (rpb + NWAVES - 1) / NWAVES;
        for (int rr_ = 0; rr_ < REP_P0R; ++rr_)
        {
            (void)rpw;
            f32x4 v[4], nx[4];
            if (gw < T) {
#pragma unroll
                for (int j = 0; j < 4; ++j) nx[j] = ((const f32x4*)(x + (size_t)gw * DM) + lane)[64 * j]; }
            for (int row = gw; row < T; row += NGW) {
#pragma unroll
                for (int j = 0; j < 4; ++j) v[j] = nx[j];
                if (row + NGW < T) {
#pragma unroll
                    for (int j = 0; j < 4; ++j) nx[j] = ((const f32x4*)(x + (size_t)(row + NGW) * DM) + lane)[64 * j]; }
                float s = 0.f;
#pragma unroll
                for (int j = 0; j < 4; ++j) s += (v[j][0] * v[j][0] + v[j][1] * v[j][1]) + (v[j][2] * v[j][2] + v[j][3] * v[j][3]);
                unsigned long long* o8 = (unsigned long long*)(XB + (size_t)row * DM) + lane;
#pragma unroll
                for (int j = 0; j < 4; ++j) o8[64 * j] = (unsigned long long)pk2(v[j][0], v[j][1]) | ((unsigned long long)pk2(v[j][2], v[j][3]) << 32);
                float d[8];
#pragma unroll
                for (int h = 0; h < 8; ++h) { d[h] = 0.f;
#pragma unroll
                    for (int j = 0; j < 4; ++j) { const f32x4 g4 = *(const LAS f32x4*)(gwt + h * 1024 + 256 * j + 4 * lane); d[h] += (v[j][0] * g4[0] + v[j][1] * g4[1]) + (v[j][2] * g4[2] + v[j][3] * g4[3]); } }
                s = wave_sum(s);
                { const bool u5 = (lane & 32) != 0, u4 = (lane & 16) != 0, u3 = (lane & 8) != 0;
#pragma unroll
                  for (int i = 0; i < 4; ++i) { const float keep = u5 ? d[i + 4] : d[i], send = u5 ? d[i] : d[i + 4]; d[i] = keep + __shfl_xor(send, 32); }
#pragma unroll
                  for (int i = 0; i < 2; ++i) { const float keep = u4 ? d[i + 2] : d[i], send = u4 ? d[i] : d[i + 2]; d[i] = keep + __shfl_xor(send, 16); }
                  { const float keep = u3 ? d[1] : d[0], send = u3 ? d[0] : d[1]; d[0] = keep + __shfl_xor(send, 8); }
                  d[0] += __shfl_xor(d[0], 4); d[0] += __shfl_xor(d[0], 2); d[0] += __shfl_xor(d[0], 1); }
                const float rs = 1.0f / sqrtf(s * (1.0f / DM) + EPS);
                if (lane == 0) SSQ0[row] = s;
                if ((lane & 7) == 0) { const int h = lane >> 3; const float z = d[0] * rs + b_forget[h]; const float lsv = fminf(z, 0.f) - log1pf(expf(-fabsf(z)));
                    const int bb = row >> 11, sp = row & 2047; __hip_atomic_store(LS + ((size_t)bb * 8 + h) * SEQ + sp, lsv, __ATOMIC_RELAXED, __HIP_MEMORY_SCOPE_AGENT); }
            }
        }
        for (int row = gw; row < TM; row += NGW) {
            const f32x4* xr = (const f32x4*)(mem + (size_t)row * DM) + lane; float s = 0.f;
            unsigned long long* o8 = (unsigned long long*)(MEMB + (size_t)row * DM) + lane;
#pragma unroll
            for (int j = 0; j < 4; ++j) { const f32x4 v = xr[64 * j]; s += (v[0] * v[0] + v[1] * v[1]) + (v[2] * v[2] + v[3] * v[3]);
                o8[64 * j] = (unsigned long long)pk2(v[0], v[1]) | ((unsigned long long)pk2(v[2], v[3]) << 32); }
            s = wave_sum(s); if (lane == 0) SSQM[row] = s;
        }
    }
    GRID_BAR();
    if (rep_ == REP_P0 - 1) {
        volatile LAS int* flagw = (volatile LAS int*)(ldsl + LDS_BYTES - 64);
        if (wave == 0) { const int l_ = hw_lane(); const unsigned* xt = (const unsigned*)opq_ptr(args.ws) + 2048; const unsigned mine = __hip_atomic_load(xt + blk, __ATOMIC_RELAXED, __HIP_MEMORY_SCOPE_AGENT); int ok = (G % 8 == 0);
            for (int b2 = l_; b2 < G; b2 += 64) { const unsigned o = __hip_atomic_load(xt + b2, __ATOMIC_RELAXED, __HIP_MEMORY_SCOPE_AGENT); if ((o == mine) != ((b2 & 7) == (blk & 7))) ok = 0; }
            ok = __all(ok); if (l_ == 0) *flagw = ok; }
        __syncthreads();
        use_xcd = __builtin_amdgcn_readfirstlane(*flagw);
        __syncthreads();
    }

    }
#endif
#ifndef SKIP_P1
    for (int rep_ = 0; rep_ < REP_P1; ++rep_) {
    DECL_PTRS
    (void)x; (void)mem; (void)out; (void)CC;
    {
        const int lane = hw_lane();
        for (int rb_ = 0; rb_ < REP_P1B; ++rb_)
        { pg8::Gemm g{XB, W1t, T, 4096, 1024}; pg8::StaticOrder S; S.init(T, 4096, G, blk);
          epi::InProj E{UB, QF, KF, VF, GT, SSQ0, b_gate};
          pg8::gemm_phase<epi::InProj, pg8::StaticOrder, PG8_ALIGN, PG8_SP2>(ldsl, g, S, E, wave); }
        { pg8::Gemm g{MEMB, Wxkv, TM, 1024, 1024}; pg8::StaticOrder S; S.init(TM, 1024, G, blk);
          epi::MemKV E{KX, VXT, SSQM};
          pg8::gemm_phase<epi::MemKV, pg8::StaticOrder, PG8_ALIGN, PG8_SP2>(ldsl, g, S, E, wave);
          pg8::Unit u0_; int nmine = 0; for (int i = 0; S.next(i, u0_); ++i) ++nmine;
          if (nmine > 0) { asm volatile("s_waitcnt vmcnt(0)" ::: "memory"); __syncthreads();
            if (wave == 0 && hw_lane() == 0) { __builtin_amdgcn_fence(__ATOMIC_RELEASE, "agent"); asm volatile("s_waitcnt vmcnt(0)" ::: "memory");
              __hip_atomic_fetch_add((unsigned*)opq_ptr(args.ws) + 64 * 10, (unsigned)nmine, __ATOMIC_RELAXED, __HIP_MEMORY_SCOPE_AGENT); } } }
    }
    if (use_xcd) XCD_BAR(); else GRID_BAR();

    }
#endif
#ifndef SKIP_P2
    for (int rep_ = 0; rep_ < REP_P2; ++rep_) {
    DECL_PTRS
    (void)x; (void)mem; (void)out; (void)CC;
    {
        const int lane = hw_lane();
        const int rpb = (T + G - 1) / G, rows_per = (rpb + NWAVES - 1) / NWAVES;
        const int gI = lane >> 4, w = 2 << gI;
        const int t_b = hb * rpb + wave * rows_per; int nr = rpb - wave * rows_per; if (nr > rows_per) nr = rows_per; if (t_b + nr > T) nr = T - t_b;
        u32x4 qn[16];
        if (nr > 0) { const int sp0 = t_b & 2047, c0_ = (sp0 + 1) < w ? (sp0 + 1) : w;
#pragma unroll
            for (int j = 0; j < 16; ++j) qn[j] = *(const u32x4*)(UB + (size_t)(j < c0_ ? t_b - j : t_b) * 512 + lane * 8); }
        for (int i = 0; i < nr; ++i) { const int t = t_b + i;
            const int sp = t & 2047, cnt = (sp + 1) < w ? (sp + 1) : w;
            u32x4 qv[16];
#pragma unroll
            for (int j = 0; j < 16; ++j) qv[j] = qn[j];
            if (i + 1 < nr) { const int t1 = t + 1, sp1 = t1 & 2047, c1_ = (sp1 + 1) < w ? (sp1 + 1) : w;
#pragma unroll
                for (int j = 0; j < 16; ++j) qn[j] = *(const u32x4*)(UB + (size_t)(j < c1_ ? t1 - j : t1) * 512 + lane * 8); }
            float a[8];
#pragma unroll
            for (int e = 0; e < 8; ++e) a[e] = 0.f;
            const u32x4 u0 = qv[0];
#pragma unroll
            for (int j = 0; j < 16; ++j) { const float mk = j < cnt ? 1.0f : 0.0f; const u32x4 q = qv[j];
                a[0] += mk * bflo(q.x); a[1] += mk * bfhi(q.x); a[2] += mk * bflo(q.y); a[3] += mk * bfhi(q.y); a[4] += mk * bflo(q.z); a[5] += mk * bfhi(q.z); a[6] += mk * bflo(q.w); a[7] += mk * bfhi(q.w); }
            const float ic = 1.0f / (float)cnt;
            u32x4 o; o.x = pk2(a[0] * ic - bflo(u0.x), a[1] * ic - bfhi(u0.x)); o.y = pk2(a[2] * ic - bflo(u0.y), a[3] * ic - bfhi(u0.y));
            o.z = pk2(a[4] * ic - bflo(u0.z), a[5] * ic - bfhi(u0.z)); o.w = pk2(a[6] * ic - bflo(u0.w), a[7] * ic - bfhi(u0.w));
            *(u32x4*)(AD + (size_t)t * 1024 + lane * 8) = o; }
        __syncthreads();
        const attn_body::AttnTensors AT{(const attn_body::bf16*)QF, (const attn_body::bf16*)KF, (const attn_body::bf16*)VF, (attn_body::bf16*)(AD + 512), LS};
        const attn_body::StaticOrder S(G, blk);
        attn_body::attn_phase<attn_body::StaticOrder, 40>((char*)lds, AT, S, wave);
    }
    XCD_BAR();

    }
#endif
#ifndef SKIP_P3
    for (int rep_ = 0; rep_ < REP_P3; ++rep_) {
    DECL_PTRS
    (void)x; (void)mem; (void)out; (void)CC;
    { pg8::Gemm g{AD, Wmix, T, 1024, 1024}; pg8::StaticOrder S; S.init(T, 1024, G, blk);
      epi::Mix E{GT, ZB};
      pg8::gemm_phase<epi::Mix, pg8::StaticOrder, PG8_ALIGN, PG8_SP2>(ldsl, g, S, E, wave); }
    XCD_BAR();

    }
#endif
#ifndef SKIP_P4
    for (int rep_ = 0; rep_ < REP_P4; ++rep_) {
    DECL_PTRS
    (void)x; (void)mem; (void)out; (void)CC;
    { pg8::Gemm g{ZB, Wout, T, 1024, 1024}; pg8::StaticOrder S; S.init(T, 1024, G, blk);
      epi::Resid<false> E{x, X1B, SSQ1};
      pg8::gemm_phase<epi::Resid<false>, pg8::StaticOrder, PG8_ALIGN, PG8_SP2>(ldsl, g, S, E, wave); }
    XCD_BAR();

    }
#endif
#ifndef SKIP_P5A
    for (int rep_ = 0; rep_ < REP_P5A; ++rep_) {
    DECL_PTRS
    (void)x; (void)mem; (void)out; (void)CC;
    { pg8::Gemm g{X1B, Wxq, T, 512, 1024}; pg8::StaticOrder S; S.init(T, 512, G, blk);
      epi::ScaleRow E{QX, 512, SSQ1};
      pg8::gemm_phase<epi::ScaleRow, pg8::StaticOrder, PG8_ALIGN, PG8_SP2>(ldsl, g, S, E, wave); }
    XCD_BAR();

    }
#endif
#ifndef SKIP_P5B
    for (int rep_ = 0; rep_ < REP_P5B; ++rep_) {
    DECL_PTRS
    (void)x; (void)mem; (void)out; (void)CC;
    if (use_xcd) { if (wave == 0 && hw_lane() == 0) { while (__hip_atomic_load((unsigned*)opq_ptr(args.ws) + 64 * 10, __ATOMIC_RELAXED, __HIP_MEMORY_SCOPE_AGENT) < (unsigned)((TM / 256) * 4)) __builtin_amdgcn_s_sleep(2);
          __builtin_amdgcn_fence(__ATOMIC_ACQUIRE, "agent"); asm volatile("s_waitcnt vmcnt(0)" ::: "memory"); }
      __syncthreads(); }
    { const int lane = hw_lane(); const int upb = ((T / 256) * 4 + G - 1) / G; for (int i = 0; i < upb; ++i) { const int un = hb * upb + i; if (un >= (T / 256) * 4) break; xattn_unit(un >> 2, un & 3, QX, KX, VXT, OX, wave, lane, ldsl); } }
    XCD_BAR();

    }
#endif
#ifndef SKIP_P5C
    for (int rep_ = 0; rep_ < REP_P5C; ++rep_) {
    DECL_PTRS
    (void)x; (void)mem; (void)out; (void)CC;
    { pg8::Gemm g{OX, Wxo, T, 1024, 512}; pg8::StaticOrder S; S.init(T, 1024, G, blk);
      epi::Resid<true> E{X1B, X2B, SSQ2};
      pg8::gemm_phase<epi::Resid<true>, pg8::StaticOrder, PG8_ALIGN, PG8_SP2>(ldsl, g, S, E, wave); }
    XCD_BAR();

    }
#endif
#ifndef SKIP_P6
    for (int rep_ = 0; rep_ < REP_P6; ++rep_) {
    DECL_PTRS
    (void)x; (void)mem; (void)out; (void)CC;
    { pg8::Gemm g{X2B, Wffi, T, 2 * DFF, 1024}; pg8::StaticOrder S; S.init(T, 2 * DFF, G, blk);
      epi::SwiGLU E{ACT, SSQ2};
      pg8::gemm_phase<epi::SwiGLU, pg8::StaticOrder, PG8_ALIGN, PG8_SP2>(ldsl, g, S, E, wave); }
    XCD_BAR();

    }
#endif
#ifndef SKIP_P7
    for (int rep_ = 0; rep_ < REP_P7; ++rep_) {
    DECL_PTRS
    (void)x; (void)mem; (void)out; (void)CC;
    { pg8::Gemm g{ACT, Wffo, T, 1024, DFF}; pg8::StaticOrder S; S.init(T, 1024, G, blk);
      epi::Resid<true> E{X2B, X2B, SSQ3};
      pg8::gemm_phase<epi::Resid<true>, pg8::StaticOrder, PG8_ALIGN, PG8_SP2>(ldsl, g, S, E, wave); }
    XCD_BAR();

    }
#endif
#ifndef SKIP_P8
    for (int rep_ = 0; rep_ < REP_P8; ++rep_) {
    DECL_PTRS
    (void)x; (void)mem; (void)out; (void)CC;
    { const int lane = hw_lane();
    const int rpb = (T + G - 1) / G, rpw = (rpb + NWAVES - 1) / NWAVES;
    const int row_b = hb * rpb + wave * rpw; int nrows = rpb - wave * rpw; if (nrows > rpw) nrows = rpw; if (row_b + nrows > T) nrows = T - row_b;
    f32x4 gv[4];
#pragma unroll
    for (int j = 0; j < 4; ++j) gv[j] = ((const f32x4*)norm_final_g + lane)[64 * j];
    f32x4 pa_n = {0.f, 0.f, 0.f, 0.f}; unsigned long long q_n[4] = {0ull, 0ull, 0ull, 0ull};
    if (nrows > 0) { pa_n = *(const f32x4*)(SSQ3 + (size_t)row_b * 16 + 4 * (lane & 3));
#pragma unroll
        for (int j = 0; j < 4; ++j) q_n[j] = ((const unsigned long long*)(X2B + (size_t)row_b * DM) + lane)[64 * j]; }
    for (int k = 0; k < nrows; ++k) { const int row = row_b + k;
        const f32x4 pa = pa_n; unsigned long long q[4];
#pragma unroll
        for (int j = 0; j < 4; ++j) q[j] = q_n[j];
        if (k + 1 < nrows) { pa_n = *(const f32x4*)(SSQ3 + (size_t)(row + 1) * 16 + 4 * (lane & 3));
#pragma unroll
            for (int j = 0; j < 4; ++j) q_n[j] = ((const unsigned long long*)(X2B + (size_t)(row + 1) * DM) + lane)[64 * j]; }
        float s = (pa[0] + pa[1]) + (pa[2] + pa[3]); s += __shfl_xor(s, 1); s += __shfl_xor(s, 2);
        const float rs = 1.0f / sqrtf(s * (1.0f / DM) + EPS);
        f32x4* orow = (f32x4*)(out + (size_t)row * DM) + lane;
#pragma unroll
        for (int j = 0; j < 4; ++j) { const unsigned lo = (unsigned)q[j], hi = (unsigned)(q[j] >> 32);
            orow[64 * j] = (f32x4){bflo(lo), bfhi(lo), bflo(hi), bfhi(hi)} * rs * gv[j]; }
    } }
    }
#endif
}

extern "C" void kernel_launch(void* const* d_in, const int* in_sizes, int n_in, void* d_out, int out_size, void* d_ws, size_t ws_size, hipStream_t stream) {
    static int grid = 0;
    if (grid == 0) {
        if (n_in != 20 || in_sizes[0] != T * DM || out_size != T * DM || ws_size < WS_END) { fprintf(stderr, "kernel_launch: unexpected shapes (n_in %d, in0 %d, out %d, ws %zu)\n", n_in, n_in > 0 ? in_sizes[0] : -1, out_size, ws_size); grid = -1; return; }
        int dev = 0, cus = 0, per_cu = 0;
        if (hipGetDevice(&dev) != hipSuccess || hipDeviceGetAttribute(&cus, hipDeviceAttributeMultiprocessorCount, dev) != hipSuccess) { grid = -1; return; }
        if (hipFuncSetAttribute((const void*)hybrid_fwd, hipFuncAttributeMaxDynamicSharedMemorySize, LDS_BYTES) != hipSuccess) { fprintf(stderr, "kernel_launch: hipFuncSetAttribute failed\n"); grid = -1; return; }
        if (hipOccupancyMaxActiveBlocksPerMultiprocessor(&per_cu, (const void*)hybrid_fwd, NTHR, LDS_BYTES) != hipSuccess || per_cu < 1) { fprintf(stderr, "kernel_launch: occupancy query says %d blocks per CU\n", per_cu); (void)hipGetLastError(); grid = -1; return; }
        grid = cus * per_cu; if (grid > 256) grid = 256;
    }
    if (grid < 0) return;
    Args a{};
    for (int i = 0; i < 20; ++i) a.in[i] = (const float*)d_in[i];
    a.out = (float*)d_out; a.ws = (unsigned char*)d_ws;
    if (hipMemsetAsync(d_ws, 0, 4096, stream) != hipSuccess) { fprintf(stderr, "kernel_launch: memset failed\n"); return; }
    void* kargs[] = {&a};
    hipError_t e = hipLaunchCooperativeKernel((const void*)hybrid_fwd, dim3(grid), dim3(NTHR), kargs, LDS_BYTES, stream);
    if (e != hipSuccess) fprintf(stderr, "kernel_launch: cooperative launch failed: %s (grid %d)\n", hipGetErrorString(e), grid);
}
```

```cpp
#include <hip/hip_runtime.h>
#include <hip/hip_cooperative_groups.h>
#include <cstdio>
#include <cstdint>
namespace cg = cooperative_groups;
__device__ __forceinline__ int hw_lane() { int l = (int)__builtin_amdgcn_mbcnt_hi(~0u, __builtin_amdgcn_mbcnt_lo(~0u, 0u)); asm volatile("" : "+v"(l)); return l; }
namespace pg8 {
#define PG8_LAS __attribute__((address_space(3)))
typedef unsigned short bf16_t;
typedef short bf16x8 __attribute__((ext_vector_type(8)));
typedef float f32x4 __attribute__((ext_vector_type(4)));
typedef unsigned u32x4 __attribute__((ext_vector_type(4)));
constexpr int BM = 256, BK = 64, HALF = 128, HTB = HALF * BK * 2  , STAGE_BYTES = 8 * HTB, NXCD = 8, WGM = 8;

__host__ __device__ __forceinline__ int lds_byte(int r, int c) { const int st = (r >> 4) * 2 + (c >> 5), rr = r & 15, cc = c & 31, ob = rr * 64 + cc * 2; return st * 1024 + (ob ^ (((ob >> 9) & 1) << 5)); }
__host__ __device__ __forceinline__ void stage_rc(int b, int& R, int& C) { const int st = b / 1024, sb = b % 1024, swz = sb ^ (((sb >> 9) & 1) << 5); R = (st >> 1) * 16 + swz / 64; C = (st & 1) * 32 + (swz % 64) / 2; }
__host__ __device__ __forceinline__ int perm32(int rho) { const int n = rho >> 4, i = rho & 15; return 8 * (i >> 2) + 4 * n + (i & 3); }

struct Unit { int pm, pn; };
struct Gemm { const bf16_t* A; const bf16_t* Bt; int M, N, K; };

struct StaticOrder {
    int nM, nN, nwg, G, c;
    __host__ __device__ void init(int M, int N, int G_, int c_) { nM = M / BM; nN = N / BM; nwg = nM * nN; G = G_; c = c_; }
    __host__ __device__ bool next(int i, Unit& u) const {
        const long L = (long)i * G + c; if (L >= nwg) return false;
        int wgid = (int)L; { const int q = nwg / NXCD, r = nwg % NXCD, xcd = wgid % NXCD, off = wgid / NXCD; wgid = (xcd < r ? xcd * (q + 1) : r * (q + 1) + (xcd - r) * q) + off; }
        const int nig = WGM * nN, gid = wgid / nig, fm = gid * WGM, gsz = (nM - fm) < WGM ? (nM - fm) : WGM;
        u.pm = fm + ((wgid % nig) % gsz); u.pn = (wgid % nig) / gsz; return true;
    }
    __device__ __forceinline__ void a_ready(const Unit&) const {}
    __device__ __forceinline__ void done(const Unit&) const {}
};

__device__ __forceinline__ unsigned cvt_pk_bf16(float lo, float hi) { unsigned r; asm volatile("v_cvt_pk_bf16_f32 %0, %1, %2" : "=v"(r) : "v"(lo), "v"(hi)); return r; }
template <class Epi, class Sched, bool ALIGN_EPI = false, bool SP2 = false>
__device__ __forceinline__ void gemm_phase(PG8_LAS unsigned char* lds, const Gemm g, const Sched& S, const Epi& E, const int wv) {
    const int wid = wv, lane = hw_lane(), tid = wid * 64 + lane, wr = wid >> 2, wc = wid & 3, fr = lane & 15, fq = lane >> 4;
    const int K = g.K, nt = K / BK;
    unsigned voffA[2], voffB[2];
#pragma unroll
    for (int i = 0; i < 2; ++i) { int R, C; stage_rc(tid * 16 + i * 8192, R, C); const int Rb = Epi::PERM ? ((R & ~31) + perm32(R & 31)) : R;
        voffA[i] = (unsigned)(R * K + C) * 2u; voffB[i] = (unsigned)(Rb * K + C) * 2u; }
    const size_t kstep = (size_t)(BK * 2);
    const size_t hstep = (size_t)HALF * K * 2;
    const size_t tstep = 2 * hstep;
    const unsigned ldsw = (unsigned)wid * 1024u;
    const int aoff = lds_byte(wr * 64 + fr, fq * 8), boff = lds_byte(wc * 32 + fr, fq * 8);
#define PG8_SA(b, h) (((b) * 2 + (h)) * HTB)
#define PG8_SB(b, h) ((4 + (b) * 2 + (h)) * HTB)
#define PG8_STAGE(bufoff, gbase, voff) do { _Pragma("unroll") for (int _i = 0; _i < 2; ++_i) \
        __builtin_amdgcn_global_load_lds((const unsigned*)((const char*)(gbase) + (voff)[_i]), (PG8_LAS unsigned*)(lds + (bufoff) + ldsw + _i * 8192), 16, 0, 0); } while (0)
#define PG8_LDA(dst, b, h) do { _Pragma("unroll") for (int m = 0; m < 4; ++m) _Pragma("unroll") for (int k = 0; k < 2; ++k) dst[m][k] = *(const PG8_LAS bf16x8*)(lds + PG8_SA(b, h) + aoff + m * 2048 + k * 1024); } while (0)
#define PG8_LDB(dst, b, h) do { _Pragma("unroll") for (int n = 0; n < 2; ++n) _Pragma("unroll") for (int k = 0; k < 2; ++k) dst[n][k] = *(const PG8_LAS bf16x8*)(lds + PG8_SB(b, h) + boff + n * 2048 + k * 1024); } while (0)
#define PG8_MMA(ai, bj, At, Bt) do { __builtin_amdgcn_s_setprio(1); _Pragma("unroll") for (int m = 0; m < 4; ++m) _Pragma("unroll") for (int n = 0; n < 2; ++n) _Pragma("unroll") for (int k = 0; k < 2; ++k) \
        acc[ai][bj][m][n] = __builtin_amdgcn_mfma_f32_16x16x32_bf16(Bt[n][k], At[m][k], acc[ai][bj][m][n], 0, 0, 0); __builtin_amdgcn_s_setprio(0); } while (0)
#define PG8_WAIT_V(n) asm volatile("s_waitcnt vmcnt(" #n ")" ::: "memory")
#define PG8_WAIT_L(n) asm volatile("s_waitcnt lgkmcnt(" #n ")" ::: "memory")
#define PG8_BAR __builtin_amdgcn_s_barrier()
#define PG8_SCHED __builtin_amdgcn_sched_barrier(0)
    Unit cur, nxt; int ui = 0;
    if (!S.next(0, cur)) return;
    f32x4 acc[2][2][4][2];
#pragma unroll
    for (int a = 0; a < 2; ++a)
#pragma unroll
        for (int b = 0; b < 2; ++b)
#pragma unroll
            for (int m = 0; m < 4; ++m)
#pragma unroll
                for (int n = 0; n < 2; ++n) acc[a][b][m][n] = (f32x4){0.f, 0.f, 0.f, 0.f};
    bf16x8 At[4][2], B0[2][2], B1[2][2];
    const char* cA = (const char*)g.A + (size_t)cur.pm * tstep; const char* cB = (const char*)g.Bt + (size_t)cur.pn * tstep;
    S.a_ready(cur);
    if constexpr (SP2) {
        PG8_STAGE(PG8_SB(0, 0), cB, voffB); PG8_STAGE(PG8_SB(0, 1), cB + hstep, voffB); PG8_STAGE(PG8_SA(0, 0), cA, voffA); PG8_STAGE(PG8_SA(0, 1), cA + hstep, voffA);
        if (wr == 1) PG8_BAR;
        PG8_WAIT_V(2); PG8_BAR;
        PG8_STAGE(PG8_SB(1, 0), cB + kstep, voffB); PG8_STAGE(PG8_SA(1, 0), cA + kstep, voffA); PG8_STAGE(PG8_SB(1, 1), cB + hstep + kstep, voffB);
        PG8_WAIT_V(6); PG8_BAR;
    } else {
        PG8_STAGE(PG8_SB(0, 0), cB, voffB); PG8_STAGE(PG8_SA(0, 0), cA, voffA); PG8_STAGE(PG8_SB(0, 1), cB + hstep, voffB); PG8_STAGE(PG8_SA(0, 1), cA + hstep, voffA);
        if (wr == 1) PG8_BAR;
        PG8_WAIT_V(4); PG8_BAR;
        PG8_STAGE(PG8_SB(1, 0), cB + kstep, voffB); PG8_STAGE(PG8_SA(1, 0), cA + kstep, voffA); PG8_STAGE(PG8_SB(1, 1), cB + hstep + kstep, voffB);
        PG8_WAIT_V(6); PG8_BAR;
    }
    for (;;) {
        const bool has_next = S.next(ui + 1, nxt);
        const char* nA = has_next ? (const char*)g.A + (size_t)nxt.pm * tstep : cA; const char* nB = has_next ? (const char*)g.Bt + (size_t)nxt.pn * tstep : cB;
        for (int t = 0; t < nt; t += 2) {
            if constexpr (Epi::HAS_MID) { if (t == (nt >> 1)) E.mid(acc, cur, wr, wc, fr, fq); }
            const bool last = (t == nt - 2);
            const char* a1 = cA + (size_t)(t + 1) * kstep;
            const char* a2 = last ? nA : cA + (size_t)(t + 2) * kstep; const char* b2 = last ? nB : cB + (size_t)(t + 2) * kstep;
            const char* a3 = a2 + kstep; const char* b3 = b2 + kstep;
            if (last && has_next) S.a_ready(nxt);
            if constexpr (SP2) {
            PG8_LDB(B0, 0, 0); PG8_LDB(B1, 0, 1); PG8_SCHED; PG8_LDA(At, 0, 0); PG8_STAGE(PG8_SA(1, 1), a1 + hstep, voffA);
            PG8_WAIT_V(8); PG8_WAIT_L(0); PG8_BAR; PG8_MMA(0, 0, At, B0); PG8_MMA(0, 1, At, B1); PG8_BAR; PG8_SCHED;
            PG8_LDA(At, 0, 1); PG8_STAGE(PG8_SB(0, 0), b2, voffB); PG8_STAGE(PG8_SB(0, 1), b2 + hstep, voffB); PG8_STAGE(PG8_SA(0, 0), a2, voffA);
            PG8_WAIT_V(8); PG8_WAIT_L(0); PG8_BAR; PG8_MMA(1, 0, At, B0); PG8_MMA(1, 1, At, B1); PG8_BAR; PG8_SCHED;
            PG8_LDB(B0, 1, 0); PG8_LDB(B1, 1, 1); PG8_SCHED; PG8_LDA(At, 1, 0); PG8_STAGE(PG8_SA(0, 1), a2 + hstep, voffA);
            PG8_WAIT_V(8); PG8_WAIT_L(0); PG8_BAR; PG8_MMA(0, 0, At, B0); PG8_MMA(0, 1, At, B1); PG8_BAR; PG8_SCHED;
            PG8_LDA(At, 1, 1); PG8_STAGE(PG8_SB(1, 0), b3, voffB); PG8_STAGE(PG8_SB(1, 1), b3 + hstep, voffB); PG8_STAGE(PG8_SA(1, 0), a3, voffA);
            PG8_WAIT_V(8); PG8_WAIT_L(0); PG8_BAR; PG8_MMA(1, 0, At, B0); PG8_MMA(1, 1, At, B1); PG8_BAR; PG8_SCHED;
            } else {
            PG8_LDB(B0, 0, 0); PG8_SCHED; PG8_LDA(At, 0, 0); PG8_STAGE(PG8_SA(1, 1), a1 + hstep, voffA);
            PG8_WAIT_L(8); PG8_BAR; PG8_WAIT_L(0); PG8_MMA(0, 0, At, B0); PG8_BAR; PG8_SCHED;
            PG8_LDB(B1, 0, 1); PG8_STAGE(PG8_SB(0, 0), b2, voffB);
            PG8_BAR; PG8_WAIT_L(0); PG8_MMA(0, 1, At, B1); PG8_BAR;
            PG8_LDA(At, 0, 1); PG8_STAGE(PG8_SA(0, 0), a2, voffA);
            PG8_BAR; PG8_WAIT_L(0); PG8_MMA(1, 0, At, B0); PG8_BAR; PG8_SCHED;
            PG8_STAGE(PG8_SB(0, 1), b2 + hstep, voffB);
            PG8_WAIT_V(6); PG8_BAR; PG8_MMA(1, 1, At, B1); PG8_BAR;
            PG8_LDB(B0, 1, 0); PG8_SCHED; PG8_LDA(At, 1, 0); PG8_STAGE(PG8_SA(0, 1), a2 + hstep, voffA);
            PG8_WAIT_L(8); PG8_BAR; PG8_WAIT_L(0); PG8_MMA(0, 0, At, B0); PG8_BAR; PG8_SCHED;
            PG8_LDB(B1, 1, 1); PG8_STAGE(PG8_SB(1, 0), b3, voffB);
            PG8_BAR; PG8_WAIT_L(0); PG8_MMA(0, 1, At, B1); PG8_BAR;
            PG8_LDA(At, 1, 1); PG8_STAGE(PG8_SA(1, 0), a3, voffA);
            PG8_BAR; PG8_WAIT_L(0); PG8_MMA(1, 0, At, B0); PG8_BAR; PG8_SCHED;
            PG8_STAGE(PG8_SB(1, 1), b3 + hstep, voffB);
            PG8_WAIT_V(6); PG8_BAR; PG8_MMA(1, 1, At, B1); PG8_BAR;
            }
        }
        if constexpr (ALIGN_EPI) { if (wr == 0) PG8_BAR; }
        if constexpr (!Epi::AFTER_DRAIN) { E(acc, cur, wr, wc, fr, fq); S.done(cur); }
        if (!has_next) break;
#pragma unroll
        for (int a = 0; a < 2; ++a)
#pragma unroll
            for (int b = 0; b < 2; ++b)
#pragma unroll
                for (int m = 0; m < 4; ++m)
#pragma unroll
                    for (int n = 0; n < 2; ++n) acc[a][b][m][n] = (f32x4){0.f, 0.f, 0.f, 0.f};
        cur = nxt; cA = nA; cB = nB; ++ui;
        if constexpr (ALIGN_EPI) { if (wr == 1) PG8_BAR; }
    }
    PG8_WAIT_V(0);
    if constexpr (!ALIGN_EPI) { if (wr == 0) PG8_BAR; }
    PG8_BAR;
    if constexpr (Epi::AFTER_DRAIN) { E.fused(acc, cur, wr, wc, fr, fq, lds, wid, lane); S.done(cur); }
#undef PG8_SA
#undef PG8_SB
#undef PG8_STAGE
#undef PG8_LDA
#undef PG8_LDB
#undef PG8_MMA
#undef PG8_WAIT_V
#undef PG8_WAIT_L
#undef PG8_BAR
#undef PG8_SCHED
}
}
#ifndef PG8_SP2
#define PG8_SP2 true
#endif
#ifndef PG8_ALIGN
#define PG8_ALIGN true
#endif
#include <hip/hip_bf16.h>
#include <cmath>
namespace attn_body {
using bf16=__hip_bfloat16;
using bf16x8=__attribute__((ext_vector_type(8)))short;
using s16x4=__attribute__((ext_vector_type(4)))short;
using f32x16=__attribute__((ext_vector_type(16)))float;
using u32x4=__attribute__((ext_vector_type(4)))unsigned;
constexpr int BATCH=16,NHEAD=8,SEQ=2048,D=64,DM=NHEAD*D,ODM=1024;
constexpr int NW=8,QBLK=32,QB=QBLK*NW,KVBLK=64,NQB=SEQ/QB;
constexpr int ATTN_PITCH=DM, ATTN_UNIT_ROWS=QB;
__device__ __forceinline__ int crow(int r,int hi){return (r&3)+8*(r>>2)+4*hi;}
#define SBAR() __builtin_amdgcn_sched_barrier(0)
__device__ __forceinline__ void cmask(f32x16&p0,f32x16&p1,int jb,int qrel,int hi){
  const float NEG=-INFINITY; int kb=64*jb+4*hi;
  #pragma unroll
  for(int r=0;r<16;++r){int kv=kb+(r&3)+8*(r>>2); if(kv>qrel)p0[r]=NEG; if(kv+32>qrel)p1[r]=NEG;}
}

constexpr int NSLOT=3, SLOTB=8192;
constexpr int LDS_K=0, LDS_V=NSLOT*SLOTB, LDS_WS=2*NSLOT*SLOTB, LDS_OST=LDS_WS+NW*64*4, LDS_CB=LDS_OST+NW*4096, LDS_CL=LDS_CB+SEQ*4, LDS_BYTES=LDS_CL+SEQ*4;
constexpr float C2=0.125f*1.4426950408889634f;
__device__ __forceinline__ void glds16(const void*gsrc,unsigned lds_dst){unsigned keep;
  asm volatile("s_mov_b32 %0, m0\n\ts_mov_b32 m0, %2\n\ts_nop 0\n\tglobal_load_lds_dwordx4 %1, off\n\ts_mov_b32 m0, %0":"=&s"(keep):"v"(gsrc),"s"(lds_dst):"memory");}
__device__ __forceinline__ float max3f(float a,float b,float c){float r;asm("v_max3_f32 %0, %1, %2, %3":"=v"(r):"v"(a),"v"(b),"v"(c));return r;}
__device__ __forceinline__ float max2f(float a,float b){float r;asm("v_max_f32_e32 %0, %1, %2":"=v"(r):"v"(a),"v"(b));return r;}
__device__ __forceinline__ float fadd_s(float a,float b){float r;asm("v_add_f32_e32 %0, %1, %2":"=v"(r):"v"(a),"v"(b));return r;}
__device__ __forceinline__ float fsub_s(float a,float b){float r;asm("v_sub_f32_e32 %0, %1, %2":"=v"(r):"v"(a),"v"(b));return r;}
typedef float f32x2_t __attribute__((ext_vector_type(2))); typedef __bf16 bf16x2_t __attribute__((ext_vector_type(2)));
__device__ __forceinline__ unsigned cvtpk_s(float lo,float hi){f32x2_t v={lo,hi};bf16x2_t b=__builtin_convertvector(v,bf16x2_t);return __builtin_bit_cast(unsigned,b);}
#define WAIT_BAR(N) asm volatile("s_waitcnt vmcnt(" #N ") lgkmcnt(0)\n\ts_barrier":::"memory")

__device__ __forceinline__ void qkt(f32x16&p0,f32x16&p1,const char*Kslot,const bf16x8*qr,const f32x16&negm,int r32,int hi){
  const char*kb=Kslot+hi*1024+r32*16;
  #pragma unroll
  for(int d0=0;d0<4;++d0){
    const bf16x8 b0=*reinterpret_cast<const bf16x8*>(kb+d0*2048);
    const bf16x8 b1=*reinterpret_cast<const bf16x8*>(kb+d0*2048+512);
    if(d0==0){p0=__builtin_amdgcn_mfma_f32_32x32x16_bf16(b0,qr[0],negm,0,0,0);p1=__builtin_amdgcn_mfma_f32_32x32x16_bf16(b1,qr[0],negm,0,0,0);}
    else{p0=__builtin_amdgcn_mfma_f32_32x32x16_bf16(b0,qr[d0],p0,0,0,0);p1=__builtin_amdgcn_mfma_f32_32x32x16_bf16(b1,qr[d0],p1,0,0,0);}}
}
typedef __attribute__((address_space(3))) const char* lds_cptr;
typedef short v4i16_t __attribute__((ext_vector_type(4)));
__device__ __forceinline__ void kload8(bf16x8*kf,lds_cptr kp){
  kf[0]=*(const __attribute__((address_space(3))) bf16x8*)(kp);      kf[1]=*(const __attribute__((address_space(3))) bf16x8*)(kp+512);
  kf[2]=*(const __attribute__((address_space(3))) bf16x8*)(kp+2048); kf[3]=*(const __attribute__((address_space(3))) bf16x8*)(kp+2560);
  kf[4]=*(const __attribute__((address_space(3))) bf16x8*)(kp+4096); kf[5]=*(const __attribute__((address_space(3))) bf16x8*)(kp+4608);
  kf[6]=*(const __attribute__((address_space(3))) bf16x8*)(kp+6144); kf[7]=*(const __attribute__((address_space(3))) bf16x8*)(kp+6656);
}
__device__ __forceinline__ void kload2(bf16x8*kf,lds_cptr kp,int j){ kf[2*j]=*(const __attribute__((address_space(3))) bf16x8*)(kp+j*2048); kf[2*j+1]=*(const __attribute__((address_space(3))) bf16x8*)(kp+j*2048+512); }
__device__ __forceinline__ s16x4 vtr(lds_cptr p){ return __builtin_bit_cast(s16x4,__builtin_amdgcn_ds_read_tr16_b64_v4i16((__attribute__((address_space(3))) v4i16_t*)p)); }
__device__ __forceinline__ float rowmax(const f32x16&p0,const f32x16&p1){
  float a=max3f(p0[0],p0[1],p1[0]),b=max3f(p0[2],p0[3],p1[1]);a=max3f(a,p1[2],p1[3]);
  #pragma unroll
  for(int r=4;r<16;r+=4){a=max3f(a,p0[r],p0[r+1]);b=max3f(b,p0[r+2],p0[r+3]);a=max3f(a,p1[r],p1[r+1]);b=max3f(b,p1[r+2],p1[r+3]);}
  const float m=max2f(a,b);
  auto rr=__builtin_amdgcn_permlane32_swap(__float_as_uint(m),__float_as_uint(m),false,false);
  return max2f(__uint_as_float(rr[0]),__uint_as_float(rr[1]));
}
__device__ __forceinline__ void pv(f32x16*o,int vb,bf16x8 pa0,bf16x8 pa1,bf16x8 pa2,bf16x8 pa3){
  #pragma unroll
  for(int d0=0;d0<2;++d0){s16x4 lo[4],hi[4];
    #pragma unroll
    for(int ks=0;ks<4;++ks){
      asm volatile("ds_read_b64_tr_b16 %0,%1 offset:%c2":"=&v"(lo[ks]):"v"(vb),"i"(d0*4096+ks*1024):"memory");
      asm volatile("ds_read_b64_tr_b16 %0,%1 offset:%c2":"=&v"(hi[ks]):"v"(vb),"i"(d0*4096+ks*1024+512):"memory");}
    asm volatile("s_waitcnt lgkmcnt(0)":::"memory");SBAR();
    #define PK(k) (bf16x8){lo[k][0],lo[k][1],lo[k][2],lo[k][3],hi[k][0],hi[k][1],hi[k][2],hi[k][3]}
    o[d0]=__builtin_amdgcn_mfma_f32_32x32x16_bf16(pa0,PK(0),o[d0],0,0,0);
    o[d0]=__builtin_amdgcn_mfma_f32_32x32x16_bf16(pa1,PK(1),o[d0],0,0,0);
    o[d0]=__builtin_amdgcn_mfma_f32_32x32x16_bf16(pa2,PK(2),o[d0],0,0,0);
    o[d0]=__builtin_amdgcn_mfma_f32_32x32x16_bf16(pa3,PK(3),o[d0],0,0,0);
    #undef PK
  }
}

#ifndef ATTN_STORE16
#define ATTN_STORE16(p,v) (*(u32x4*)(p)=(v))
#endif
template<int THRL> __device__ __forceinline__ void attn_unit(int b,int h,int qb,const bf16*Q,const bf16*__restrict__ K,const bf16*__restrict__ V,bf16*O,char*shm,const int wv){
  {
    typedef __attribute__((address_space(3))) float* lds_fptr;
    lds_fptr tb=(lds_fptr)((__attribute__((address_space(3))) char*)shm+LDS_CB); lds_fptr cl=(lds_fptr)((__attribute__((address_space(3))) char*)shm+LDS_CL);
    const float c0=cl[qb*QB];
    int t0_=wv*64+hw_lane(); asm volatile("":"+v"(t0_));
    _Pragma("unroll 1") for(int i=t0_;i<qb*QB+QB;i+=NW*64) tb[i]=(c0-cl[i])*1.4426950408889634f;
  }
  const int lane=hw_lane(),r32=lane&31,hi=lane>>5; const int wid=wv,tid=wid*64+lane; (void)tid;
  const long rowbase=(long)b*SEQ; const int q0=qb*QB;
  const bf16*Qw=Q+(rowbase+q0+wid*QBLK)*DM+h*D;
  const bf16*Kh=K+rowbase*DM+h*D,*Vh=V+rowbase*DM+h*D;
  const unsigned lds0=(unsigned)(uintptr_t)shm;
  float*wsf=(float*)(shm+LDS_WS)+wid*64;
  const bf16*ksrc=Kh+(long)lane*DM+wid*8;
  const bf16*vsrc=Vh+(long)(16*(wid&3)+(lane>>2))*DM+(wid>>2)*32+(lane&3)*8;
  const unsigned kdst=lds0+LDS_K+wid*1024, vdst=lds0+LDS_V+wid*1024;
  #define DMA_K(t,slot) glds16(ksrc+(long)(t)*KVBLK*DM,(unsigned)__builtin_amdgcn_readfirstlane(kdst+(slot)))
  #define DMA_V(t,slot) glds16(vsrc+(long)(t)*KVBLK*DM,(unsigned)__builtin_amdgcn_readfirstlane(vdst+(slot)))
  const int vb0=(int)(lds0+LDS_V)+((lane>>4)&1)*32+(lane&3)*8+(4*hi+((lane&15)>>2))*64;
  const char*Kbase=shm+LDS_K; bf16x8 kf[8];
  const lds_cptr shm3=(lds_cptr)shm; const lds_cptr kp0=shm3+LDS_K+hi*1024+r32*16; const lds_cptr vp0=shm3+LDS_V+((lane>>4)&1)*32+(lane&3)*8+(4*hi+((lane&15)>>2))*64;
  const int NT=(q0+QB)/KVBLK;
  DMA_K(0,0);DMA_V(0,0);DMA_K(1,SLOTB);
  bf16x8 qr[4];
  #pragma unroll
  for(int d0=0;d0<4;++d0)qr[d0]=*reinterpret_cast<const bf16x8*>(&Qw[(long)r32*DM+d0*16+hi*8]);
  float mhat=0.f,l_reg=0.f;f32x16 o[2];o[0]=f32x16{};o[1]=f32x16{};f32x16 negm=f32x16{};asm volatile("":"+v"(negm));
  const int qrel=wid*QBLK+r32;
  typedef float f32x4b __attribute__((ext_vector_type(4)));
  #define BIAS(P0,P1,t) do{ int hv_=hi; asm volatile("":"+v"(hv_)); const __attribute__((address_space(3))) f32x4b* cb4=(const __attribute__((address_space(3))) f32x4b*)(shm3+LDS_CB)+hv_; _Pragma("unroll") for(int j_=0;j_<4;++j_){ { const f32x4b a_=cb4[16*(t)+2*j_]; \
      P0[4*j_]+=a_[0];P0[4*j_+1]+=a_[1];P0[4*j_+2]+=a_[2];P0[4*j_+3]+=a_[3]; } SBAR(); { const f32x4b b_=cb4[16*(t)+2*j_+8]; P1[4*j_]+=b_[0];P1[4*j_+1]+=b_[1];P1[4*j_+2]+=b_[2];P1[4*j_+3]+=b_[3]; } SBAR(); } }while(0)
  #define CMASK(P0,P1,t) do{int jb_=(t)-(NT-4); if(jb_>=0){int q_=qrel,h_=hi; asm volatile("":"+v"(q_),"+v"(h_)); cmask(P0,P1,jb_,q_,h_);}}while(0)
  bool resc=false;
  #define START(P0,P1) do{ const float rm=rowmax(P0,P1); resc=false; \
    { const float dl=rm; mhat=fadd_s(mhat,dl); \
      _Pragma("unroll") for(int r=0;r<16;++r){P0[r]=fsub_s(P0[r],dl);P1[r]=fsub_s(P1[r],dl);} \
      _Pragma("unroll") for(int r=0;r<16;++r)negm[r]=-mhat; asm volatile("":"+v"(negm)); } \
    _Pragma("unroll") for(int r=0;r<16;++r)P0[r]=__builtin_amdgcn_exp2f(P0[r]); }while(0)
  #define RESC() do{ if(resc){ asm volatile("s_waitcnt lgkmcnt(0)":::"memory"); \
      _Pragma("unroll") for(int d_=0;d_<2;++d_) _Pragma("unroll") for(int r=0;r<16;++r)o[d_][r]*=wsf[crow(r,hi)]; } }while(0)
  f32x16 pA0,pA1,pB0,pB1;
  int sl_prev=0,sl_cur=0,sl_next=SLOTB;
  #define ROT() do{sl_prev=sl_cur;sl_cur=sl_next;sl_next=(sl_next==(NSLOT-1)*SLOTB)?0:sl_next+SLOTB;}while(0)
  DMA_K(2,2*SLOTB);
  WAIT_BAR(3);
  qkt(pA0,pA1,Kbase,qr,negm,r32,hi);asm volatile("s_nop 15\n\ts_nop 7":"+v"(pA0),"+v"(pA1));BIAS(pA0,pA1,0);CMASK(pA0,pA1,0);
  START(pA0,pA1);
  _Pragma("unroll") for(int r=0;r<16;++r)pA1[r]=__builtin_amdgcn_exp2f(pA1[r]);
  WAIT_BAR(0);
  DMA_K(3,0);DMA_V(1,SLOTB);
  ROT();
  kload8(kf,kp0+sl_cur);
  WAIT_BAR(2);
  s16x4 vlo[8],vhi[8]; u32x4 pw0,pw1,pw2,pw3;
  #define PKW(P,B) cvtpk_s(P[B],P[B+1])
  #define PAF(k) __builtin_bit_cast(bf16x8,pw##k)
  #define VFR(i) (bf16x8){vlo[i][0],vlo[i][1],vlo[i][2],vlo[i][3],vhi[i][0],vhi[i][1],vhi[i][2],vhi[i][3]}
  #define PIN(x) asm volatile("":"+v"(x))
  #define MX3(a,b,c) __builtin_fmaxf(__builtin_fmaxf((a),(b)),(c))
  #define GAPA(MF,A0,A1,A2,A3,W0,W1,PW) do{ MF; sacc+=A0; sacc+=A1; sacc+=A2; sacc+=A3; PIN(sacc); W0; W1; PIN(PW); SBAR(); }while(0)
  #define EX(v) __builtin_amdgcn_exp2f(v)
  #define GAPB(MF,X,B) do{ MF; X[B]=EX(X[B]); X[B+1]=EX(X[B+1]); X[B+2]=EX(X[B+2]); X[B+3]=EX(X[B+3]); PIN(X); SBAR(); }while(0)
  #define VRD(i) do{ vlo[i]=vtr(vp_+(((i)>>2)*4096+((i)&3)*1024)); vhi[i]=vtr(vp_+(((i)>>2)*4096+((i)&3)*1024+512)); }while(0)
  #define KRD(G,j) do{ if(G){ kload2(kf,kp0+sl_next,j); SBAR(); } }while(0)
  #define STEP(C0,C1,P0,P1,t,GK,GV,GL) do{ SBAR(); \
    const lds_cptr vp_=vp0+sl_prev; \
    VRD(0); SBAR(); float sacc=(P0[0]+P0[1]); \
    GAPA(C0=__builtin_amdgcn_mfma_f32_32x32x16_bf16(kf[0],qr[0],negm,0,0,0), P0[2],P0[3],P0[4],P0[5],     pw0[0]=PKW(P0,0), pw0[1]=PKW(P0,2), pw0); \
    VRD(4); SBAR(); GAPA(C1=__builtin_amdgcn_mfma_f32_32x32x16_bf16(kf[1],qr[0],negm,0,0,0), P0[6],P0[7],P0[8],P0[9],     pw0[2]=PKW(P0,4), pw0[3]=PKW(P0,6), pw0); \
    VRD(1); SBAR(); GAPA(C0=__builtin_amdgcn_mfma_f32_32x32x16_bf16(kf[2],qr[1],C0,0,0,0),   P0[10],P0[11],P0[12],P0[13], pw1[0]=PKW(P0,8), pw1[1]=PKW(P0,10), pw1); \
    VRD(5); SBAR(); GAPA(C1=__builtin_amdgcn_mfma_f32_32x32x16_bf16(kf[3],qr[1],C1,0,0,0),   P0[14],P0[15],P1[0],P1[1],   pw1[2]=PKW(P0,12),pw1[3]=PKW(P0,14), pw1); \
    VRD(2); SBAR(); GAPA(C0=__builtin_amdgcn_mfma_f32_32x32x16_bf16(kf[4],qr[2],C0,0,0,0),   P1[2],P1[3],P1[4],P1[5],     pw2[0]=PKW(P1,0), pw2[1]=PKW(P1,2), pw2); \
    VRD(6); SBAR(); GAPA(C1=__builtin_amdgcn_mfma_f32_32x32x16_bf16(kf[5],qr[2],C1,0,0,0),   P1[6],P1[7],P1[8],P1[9],     pw2[2]=PKW(P1,4), pw2[3]=PKW(P1,6), pw2); \
    VRD(3); SBAR(); GAPA(C0=__builtin_amdgcn_mfma_f32_32x32x16_bf16(kf[6],qr[3],C0,0,0,0),   P1[10],P1[11],P1[12],P1[13], pw3[0]=PKW(P1,8), pw3[1]=PKW(P1,10), pw3); \
    VRD(7); SBAR(); GAPA(C1=__builtin_amdgcn_mfma_f32_32x32x16_bf16(kf[7],qr[3],C1,0,0,0),   P1[14],P1[15],0.f,0.f,       pw3[2]=PKW(P1,12),pw3[3]=PKW(P1,14), pw3); \
    l_reg+=sacc; \
    if(GK){DMA_K((t)+3,sl_cur);} if(GV){DMA_V((t)+1,sl_next);} \
    BIAS(C0,C1,t); CMASK(C0,C1,t); \
    { float a=MX3(C0[0],C0[1],C1[0]),b=MX3(C0[2],C0[3],C1[1]); a=MX3(a,C1[2],C1[3]); \
      _Pragma("unroll") for(int r=4;r<16;r+=4){a=MX3(a,C0[r],C0[r+1]);b=MX3(b,C0[r+2],C0[r+3]);a=MX3(a,C1[r],C1[r+1]);b=MX3(b,C1[r+2],C1[r+3]);} \
      float rm=__builtin_fmaxf(a,b); { auto rr=__builtin_amdgcn_permlane32_swap(__float_as_uint(rm),__float_as_uint(rm),false,false); rm=__builtin_fmaxf(__uint_as_float(rr[0]),__uint_as_float(rr[1])); } \
      resc=false; \
      if(__builtin_expect(__any(rm>(float)THRL),0)){ const float dl=__builtin_fmaxf(rm,0.f); mhat+=dl; \
        _Pragma("unroll") for(int r=0;r<16;++r){C0[r]-=dl;C1[r]-=dl;} \
        _Pragma("unroll") for(int r=0;r<16;++r)negm[r]=-mhat; asm volatile("":"+v"(negm)); \
        const float f=__builtin_amdgcn_exp2f(-dl); l_reg*=f; if(hi==0)wsf[r32]=f; resc=true; } } \
    SBAR(); \
    GAPB(o[0]=__builtin_amdgcn_mfma_f32_32x32x16_bf16(PAF(0),VFR(0),o[0],0,0,0), C0,0); \
    GAPB(o[1]=__builtin_amdgcn_mfma_f32_32x32x16_bf16(PAF(0),VFR(4),o[1],0,0,0), C0,4); \
    KRD(GL,0); GAPB(o[0]=__builtin_amdgcn_mfma_f32_32x32x16_bf16(PAF(1),VFR(1),o[0],0,0,0), C0,8); \
    KRD(GL,1); GAPB(o[1]=__builtin_amdgcn_mfma_f32_32x32x16_bf16(PAF(1),VFR(5),o[1],0,0,0), C0,12); \
    KRD(GL,2); GAPB(o[0]=__builtin_amdgcn_mfma_f32_32x32x16_bf16(PAF(2),VFR(2),o[0],0,0,0), C1,0); \
    KRD(GL,3); GAPB(o[1]=__builtin_amdgcn_mfma_f32_32x32x16_bf16(PAF(2),VFR(6),o[1],0,0,0), C1,4); \
    GAPB(o[0]=__builtin_amdgcn_mfma_f32_32x32x16_bf16(PAF(3),VFR(3),o[0],0,0,0), C1,8); \
    GAPB(o[1]=__builtin_amdgcn_mfma_f32_32x32x16_bf16(PAF(3),VFR(7),o[1],0,0,0), C1,12); \
    }while(0)
  int t=1;
  #undef CMASK
  #define CMASK(P0,P1,t) do{}while(0)
  for(;t+5<NT;t+=2){
    STEP(pB0,pB1,pA0,pA1,t,true,true,true);     WAIT_BAR(2); RESC(); ROT();
    STEP(pA0,pA1,pB0,pB1,t+1,true,true,true);   WAIT_BAR(2); RESC(); ROT();
  }
  #undef CMASK
  #define CMASK(P0,P1,t) do{int jb_=(t)-(NT-4); if(jb_>=0){int q_=qrel,h_=hi; asm volatile("":"+v"(q_),"+v"(h_)); cmask(P0,P1,jb_,q_,h_);}}while(0)
  #define ENDW(tt) do{ if((tt)+3<NT){WAIT_BAR(2);} else if((tt)+2<NT){WAIT_BAR(1);} else {WAIT_BAR(0);} }while(0)
  for(;t+1<NT;t+=2){
    STEP(pB0,pB1,pA0,pA1,t,(t+3<NT),(t+1<NT),(t+1<NT));       ENDW(t);   RESC(); ROT();
    STEP(pA0,pA1,pB0,pB1,t+1,(t+4<NT),(t+2<NT),(t+2<NT));     ENDW(t+1); RESC(); ROT();
  }
  STEP(pB0,pB1,pA0,pA1,NT-1,false,false,false); RESC();
  { float sacc=pB0[0]+pB0[1]; _Pragma("unroll") for(int r=2;r<16;++r)sacc+=pB0[r]; _Pragma("unroll") for(int r=0;r<16;++r)sacc+=pB1[r]; l_reg+=sacc;
    pw0=(u32x4){PKW(pB0,0),PKW(pB0,2),PKW(pB0,4),PKW(pB0,6)};pw1=(u32x4){PKW(pB0,8),PKW(pB0,10),PKW(pB0,12),PKW(pB0,14)};pw2=(u32x4){PKW(pB1,0),PKW(pB1,2),PKW(pB1,4),PKW(pB1,6)};pw3=(u32x4){PKW(pB1,8),PKW(pB1,10),PKW(pB1,12),PKW(pB1,14)};
    SBAR(); pv(o,vb0+sl_cur,PAF(0),PAF(1),PAF(2),PAF(3)); }
  #undef PKW
  #undef PAF
  #undef VFR
  #undef PIN
  #undef MX3
  #undef GAPA
  #undef GAPB
  #undef EX
  #undef VRD
  #undef KRD
  #undef STEP
  #undef ENDW
  {auto rr=__builtin_amdgcn_permlane32_swap(__float_as_uint(l_reg),__float_as_uint(l_reg),false,false);l_reg=__uint_as_float(rr[0])+__uint_as_float(rr[1]);}
  if(hi==0)wsf[32+r32]=l_reg;asm volatile("s_waitcnt lgkmcnt(0)":::"memory");
  float rli[16];
  #pragma unroll
  for(int r=0;r<16;++r)rli[r]=__builtin_amdgcn_rcpf(wsf[32+crow(r,hi)]);
  bf16*Ow=O+(rowbase+q0+wid*QBLK)*ODM+h*D;
  { bf16*stg=(bf16*)(shm+LDS_OST)+wid*2048;
    #pragma unroll
    for(int r=0;r<16;++r){const int orow=crow(r,hi);
      #pragma unroll
      for(int d0=0;d0<2;++d0)stg[orow*64+d0*32+r32]=__float2bfloat16(o[d0][r]*rli[r]);}
    asm volatile("s_waitcnt lgkmcnt(0)":::"memory");
    #pragma unroll
    for(int i=0;i<4;++i){const int row=i*8+(lane>>3),ch=lane&7; const u32x4 v=*(const u32x4*)(stg+row*64+ch*8); ATTN_STORE16(Ow+(long)row*ODM+ch*8,v);} }
  asm volatile("s_waitcnt lgkmcnt(0)\n\ts_barrier":::"memory");
  #undef DMA_K
  #undef DMA_V
  #undef CMASK
  #undef START
  #undef RESC
  #undef BIAS
  #undef ROT
}
constexpr int ATTN_LDS_BYTES=LDS_BYTES;
struct AttnTensors { const bf16* Q; const bf16* K; const bf16* V; bf16* O; const float* LS; };
struct AttnUnit { int bh; int qb; };
struct StaticOrder {
  int G, blk;
  __device__ __forceinline__ explicit StaticOrder(int grid,int block):G(grid),blk(block){}
  __device__ __forceinline__ bool next(int i,AttnUnit&u)const{
    if(G==256){ if(i>=4)return false; const int v=(blk%8)*32+blk/8, e=v&1; u.bh=v>>1; u.qb=(i&1)?(8-i-e):(i+e); return true; }
    const int idx=i*G+blk; if(idx>=BATCH*NHEAD*NQB)return false; u.bh=idx/NQB; u.qb=NQB-1-(idx%NQB); return true; }
  __device__ __forceinline__ void a_ready(const AttnUnit&)const{}
  __device__ __forceinline__ void done(const AttnUnit&)const{}
};
template<class Sched,int THRL=8> __device__ __forceinline__ void attn_phase(char*lds,const AttnTensors&T,const Sched&S,const int wv){
  AttnUnit u; int cur_bh=-1;
  for(int i=0;S.next(i,u);++i){ S.a_ready(u);
    if(u.bh!=cur_bh){ cur_bh=u.bh;
      if(wv==0){ const int lane=hw_lane(); const float* p=T.LS+(long)u.bh*SEQ+32*lane; float v[32]; float run=0.f;
        _Pragma("unroll") for(int j=0;j<32;++j){ v[j]=__hip_atomic_load(p+j,__ATOMIC_RELAXED,__HIP_MEMORY_SCOPE_AGENT); }
        _Pragma("unroll") for(int j=0;j<32;++j){ run+=v[j]; v[j]=run; }
        float incl=run;
        _Pragma("unroll") for(int o=1;o<64;o<<=1){ const float t=__shfl_up(incl,o); if(lane>=o)incl+=t; }
        const float excl=incl-run;
        __attribute__((address_space(3))) float* cl=(__attribute__((address_space(3))) float*)((__attribute__((address_space(3))) char*)lds+LDS_CL)+32*lane;
        _Pragma("unroll") for(int j=0;j<32;++j) cl[j]=v[j]+excl; }
      asm volatile("s_waitcnt lgkmcnt(0)\n\ts_barrier":::"memory"); }
    attn_unit<THRL>(u.bh/NHEAD,u.bh%NHEAD,u.qb,T.Q,T.K,T.V,T.O,lds,wv); S.done(u); }
}
#undef SBAR
#undef WAIT_BAR
}

#define LAS __attribute__((address_space(3)))
typedef unsigned short bf16;
typedef float f32x4 __attribute__((ext_vector_type(4)));
typedef float f32x16 __attribute__((ext_vector_type(16)));
typedef unsigned u32x4 __attribute__((ext_vector_type(4)));
typedef unsigned u32x2 __attribute__((ext_vector_type(2)));
typedef short bf16x8 __attribute__((ext_vector_type(8)));
constexpr int NB = 16, SEQ = 2048, DM = 1024, T = NB * SEQ, NMEM = 256, TM = NB * NMEM;
constexpr int INC = 4104, DFF = 2816;
constexpr float EPS = 1e-6f, LOG2E = 1.4426950408889634f;
constexpr int NWAVES = 8, NTHR = 512;
constexpr int LDS_BYTES = 147456;
constexpr size_t MiB = 1u << 20;
constexpr size_t WS_W1 = 1 * MiB, WS_WPC = 9 * MiB, WS_WFO = 10 * MiB, WS_WOUT = 11 * MiB, WS_WXQ = 13 * MiB, WS_WXKV = 14 * MiB, WS_WXO = 16 * MiB,
                 WS_WFFI = 17 * MiB, WS_WFFO = 28 * MiB, WS_MEMB = 34 * MiB, WS_KX = 42 * MiB, WS_VXT = 46 * MiB, WS_LS = 50 * MiB, WS_C = 51 * MiB,
                 WS_SSQ0 = 52 * MiB, WS_SSQM = 52 * MiB + 256 * 1024, WS_SSQ1 = 53 * MiB, WS_SSQ2 = 55 * MiB, WS_SSQ3 = 57 * MiB,
                 WS_RA = 60 * MiB  , WS_RB = 124 * MiB  , WS_RC = 252 * MiB  , WS_RD = 348 * MiB  , WS_END = 380 * MiB;

__device__ __forceinline__ float bf2f(unsigned short b) { return __builtin_bit_cast(float, (unsigned)b << 16); }
__device__ __forceinline__ float bflo(unsigned w) { return __builtin_bit_cast(float, w << 16); }
__device__ __forceinline__ float bfhi(unsigned w) { return __builtin_bit_cast(float, w & 0xffff0000u); }
__device__ __forceinline__ unsigned pk2(float lo, float hi) { return pg8::cvt_pk_bf16(lo, hi); }
__device__ __forceinline__ float fsigmoid(float z) { return __builtin_amdgcn_rcpf(1.0f + __builtin_amdgcn_exp2f(-LOG2E * z)); }
__device__ __forceinline__ float rstd_of(float ssq) { return __builtin_amdgcn_rsqf(ssq * (1.0f / DM) + EPS); }
__device__ __forceinline__ float wave_sum(float v) {
#pragma unroll
    for (int o = 1; o < 64; o <<= 1) v += __shfl_xor(v, o);
    return v;
}
__device__ __forceinline__ float rstd_from_partials(const float* ssqp, int r, int fq) {
    const f32x4 p = *(const f32x4*)(ssqp + (size_t)r * 16 + 4 * fq);
    float s = (p[0] + p[1]) + (p[2] + p[3]);
    s += __shfl_xor(s, 16); s += __shfl_xor(s, 32);
    return rstd_of(s);
}

namespace epi {
using pg8::Unit;
constexpr float C2Q = 0.125f * LOG2E;
struct InProj {
    static constexpr bool PERM = true, AFTER_DRAIN = false, HAS_MID = false;
    bf16 *U, *Q, *K, *V, *G; const float* ssq0; const float* b_gate;
    __device__ __forceinline__ void operator()(const f32x4 (&acc)[2][2][4][2], const Unit& u, int wr, int wc, int fr, int fq) const {
        const int row0 = u.pm * 256 + wr * 64 + fr, ct = wc * 32 + 8 * fq, pn = u.pn;
        if (pn < 8) {
            const int sel = pn >> 1; bf16* base = sel == 0 ? U : sel == 1 ? Q : sel == 2 ? K : V; const float cs = sel == 1 ? C2Q : 1.0f;
            const int cc = (pn & 1) * 256 + ct;
#pragma unroll
            for (int ai = 0; ai < 2; ++ai)
#pragma unroll
                for (int m = 0; m < 4; ++m) { const int r = row0 + ai * 128 + m * 16; const float rs = rstd_of(ssq0[r]) * cs;
#pragma unroll
                    for (int bj = 0; bj < 2; ++bj) { const f32x4 v0 = acc[ai][bj][m][0] * rs, v1 = acc[ai][bj][m][1] * rs;
                        u32x4 w; w.x = pk2(v0[0], v0[1]); w.y = pk2(v0[2], v0[3]); w.z = pk2(v1[0], v1[1]); w.w = pk2(v1[2], v1[3]);
                        *(u32x4*)(base + (size_t)r * 512 + cc + bj * 128) = w; } }
        } else {
            const int gc = (pn - 8) * 256 + ct;
            f32x4 bv[2][2];
#pragma unroll
            for (int bj = 0; bj < 2; ++bj)
#pragma unroll
                for (int n = 0; n < 2; ++n) bv[bj][n] = *(const f32x4*)(b_gate + gc + bj * 128 + 4 * n);
#pragma unroll
            for (int ai = 0; ai < 2; ++ai)
#pragma unroll
                for (int m = 0; m < 4; ++m) { const int r = row0 + ai * 128 + m * 16; const float rs = rstd_of(ssq0[r]);
#pragma unroll
                    for (int bj = 0; bj < 2; ++bj) { const f32x4 z0 = acc[ai][bj][m][0] * rs + bv[bj][0], z1 = acc[ai][bj][m][1] * rs + bv[bj][1];
                        u32x4 w; w.x = pk2(fsigmoid(z0[0]), fsigmoid(z0[1])); w.y = pk2(fsigmoid(z0[2]), fsigmoid(z0[3])); w.z = pk2(fsigmoid(z1[0]), fsigmoid(z1[1])); w.w = pk2(fsigmoid(z1[2]), fsigmoid(z1[3]));
                        *(u32x4*)(G + (size_t)r * 2048 + gc + bj * 128) = w; } }
        }
    }
};
struct MemKV {
    static constexpr bool PERM = true, AFTER_DRAIN = false, HAS_MID = false;
    bf16 *KX, *VXT; const float* ssqm;
    __device__ __forceinline__ void operator()(const f32x4 (&acc)[2][2][4][2], const Unit& u, int wr, int wc, int fr, int fq) const {
        const int row0 = u.pm * 256 + wr * 64 + fr, ct = wc * 32 + 8 * fq, pn = u.pn;
#pragma unroll
        for (int ai = 0; ai < 2; ++ai)
#pragma unroll
            for (int m = 0; m < 4; ++m) { const int r = row0 + ai * 128 + m * 16; const float rs = rstd_of(ssqm[r]);
#pragma unroll
                for (int bj = 0; bj < 2; ++bj) { const f32x4 v0 = acc[ai][bj][m][0] * rs, v1 = acc[ai][bj][m][1] * rs;
                    if (pn < 2) { u32x4 w; w.x = pk2(v0[0], v0[1]); w.y = pk2(v0[2], v0[3]); w.z = pk2(v1[0], v1[1]); w.w = pk2(v1[2], v1[3]);
                        *(u32x4*)(KX + (size_t)r * 512 + pn * 256 + bj * 128 + ct) = w; }
                    else { const int b = r >> 8, mk = r & 255, pos = (mk & ~12) | ((mk & 4) << 1) | ((mk & 8) >> 1); const int c0 = (pn - 2) * 256 + bj * 128 + ct;
                        bf16* vp = VXT + ((size_t)b * 512 + c0) * 256 + pos;
                        const unsigned w0 = pk2(v0[0], v0[1]), w1 = pk2(v0[2], v0[3]), w2 = pk2(v1[0], v1[1]), w3 = pk2(v1[2], v1[3]);
                        vp[0 * 256] = (bf16)w0; vp[1 * 256] = (bf16)(w0 >> 16); vp[2 * 256] = (bf16)w1; vp[3 * 256] = (bf16)(w1 >> 16);
                        vp[4 * 256] = (bf16)w2; vp[5 * 256] = (bf16)(w2 >> 16); vp[6 * 256] = (bf16)w3; vp[7 * 256] = (bf16)(w3 >> 16); } } }
    }
};
struct Mix {
    static constexpr bool PERM = true, AFTER_DRAIN = false, HAS_MID = true;
    const bf16* G; bf16* Z;
    __device__ __forceinline__ void mid(f32x4 (&acc)[2][2][4][2], const Unit& u, int wr, int wc, int fr, int fq) const {
        const bf16* gb = G + (size_t)(u.pm * 256 + wr * 64 + fr) * 2048 + u.pn * 256 + wc * 32 + 8 * fq;
#pragma unroll
        for (int ai = 0; ai < 2; ++ai) { asm volatile("" : "+v"(gb));
            u32x4 gp[4][2], gf[4][2];
#pragma unroll
            for (int m = 0; m < 4; ++m)
#pragma unroll
                for (int bj = 0; bj < 2; ++bj) { const bf16* gr = gb + (size_t)(ai * 128 + m * 16) * 2048 + bj * 128; gp[m][bj] = *(const u32x4*)gr; gf[m][bj] = *(const u32x4*)(gr + 1024); }
#pragma unroll
            for (int m = 0; m < 4; ++m)
#pragma unroll
                for (int bj = 0; bj < 2; ++bj) { const u32x4 p = gp[m][bj], f = gf[m][bj];
                    acc[ai][bj][m][0][0] *= bflo(p.x) * __builtin_amdgcn_rcpf(bflo(f.x)); acc[ai][bj][m][0][1] *= bfhi(p.x) * __builtin_amdgcn_rcpf(bfhi(f.x));
                    acc[ai][bj][m][0][2] *= bflo(p.y) * __builtin_amdgcn_rcpf(bflo(f.y)); acc[ai][bj][m][0][3] *= bfhi(p.y) * __builtin_amdgcn_rcpf(bfhi(f.y));
                    acc[ai][bj][m][1][0] *= bflo(p.z) * __builtin_amdgcn_rcpf(bflo(f.z)); acc[ai][bj][m][1][1] *= bfhi(p.z) * __builtin_amdgcn_rcpf(bfhi(f.z));
                    acc[ai][bj][m][1][2] *= bflo(p.w) * __builtin_amdgcn_rcpf(bflo(f.w)); acc[ai][bj][m][1][3] *= bfhi(p.w) * __builtin_amdgcn_rcpf(bfhi(f.w)); }
            __builtin_amdgcn_sched_barrier(0); }
    }
    __device__ __forceinline__ void operator()(const f32x4 (&acc)[2][2][4][2], const Unit& u, int wr, int wc, int fr, int fq) const {
        const int row0 = u.pm * 256 + wr * 64 + fr, c0 = u.pn * 256 + wc * 32 + 8 * fq;
#pragma unroll
        for (int ai = 0; ai < 2; ++ai) { u32x4 gf[4][2];
#pragma unroll
            for (int m = 0; m < 4; ++m)
#pragma unroll
                for (int bj = 0; bj < 2; ++bj) gf[m][bj] = *(const u32x4*)(G + (size_t)(row0 + ai * 128 + m * 16) * 2048 + 1024 + c0 + bj * 128);
#pragma unroll
            for (int m = 0; m < 4; ++m) { const int r = row0 + ai * 128 + m * 16;
#pragma unroll
                for (int bj = 0; bj < 2; ++bj) { const u32x4 f = gf[m][bj]; const f32x4 a0 = acc[ai][bj][m][0], a1 = acc[ai][bj][m][1];
                    u32x4 w; w.x = pk2(a0[0] * bflo(f.x), a0[1] * bfhi(f.x)); w.y = pk2(a0[2] * bflo(f.y), a0[3] * bfhi(f.y)); w.z = pk2(a1[0] * bflo(f.z), a1[1] * bfhi(f.z)); w.w = pk2(a1[2] * bflo(f.w), a1[3] * bfhi(f.w));
                    *(u32x4*)(Z + (size_t)r * 1024 + c0 + bj * 128) = w; } }
            asm volatile("" ::: "memory"); }
    }
};
template <bool BF> struct Resid {
    static constexpr bool PERM = true, AFTER_DRAIN = false, HAS_MID = false;
    const void* base; bf16* outb; float* ssqp;
    __device__ __forceinline__ void operator()(const f32x4 (&acc)[2][2][4][2], const Unit& u, int wr, int wc, int fr, int fq) const {
        const int row0 = u.pm * 256 + wr * 64 + fr, c0 = u.pn * 256 + wc * 32 + 8 * fq;
        constexpr int MB = BF ? 4 : 2;
#pragma unroll
        for (int ai = 0; ai < 2; ++ai)
#pragma unroll
            for (int m0 = 0; m0 < 4; m0 += MB) {
                f32x4 b0[MB][2], b1[MB][2]; u32x4 qq[MB][2];
#pragma unroll
                for (int mm = 0; mm < MB; ++mm)
#pragma unroll
                    for (int bj = 0; bj < 2; ++bj) { const size_t off = (size_t)(row0 + ai * 128 + (m0 + mm) * 16) * 1024 + c0 + bj * 128;
                        if (BF) qq[mm][bj] = *(const u32x4*)((const bf16*)base + off);
                        else { b0[mm][bj] = *(const f32x4*)((const float*)base + off); b1[mm][bj] = *(const f32x4*)((const float*)base + off + 4); } }
#pragma unroll
                for (int mm = 0; mm < MB; ++mm) { const int m = m0 + mm, r = row0 + ai * 128 + m * 16; float s = 0.f;
#pragma unroll
                    for (int bj = 0; bj < 2; ++bj) { const size_t off = (size_t)r * 1024 + c0 + bj * 128; f32x4 x0, x1;
                        if (BF) { const u32x4 q = qq[mm][bj]; x0 = (f32x4){bflo(q.x), bfhi(q.x), bflo(q.y), bfhi(q.y)}; x1 = (f32x4){bflo(q.z), bfhi(q.z), bflo(q.w), bfhi(q.w)}; }
                        else { x0 = b0[mm][bj]; x1 = b1[mm][bj]; }
                        const f32x4 v0 = x0 + acc[ai][bj][m][0], v1 = x1 + acc[ai][bj][m][1];
                        u32x4 w; w.x = pk2(v0[0], v0[1]); w.y = pk2(v0[2], v0[3]); w.z = pk2(v1[0], v1[1]); w.w = pk2(v1[2], v1[3]); *(u32x4*)(outb + off) = w;
                        const float r0 = bflo(w.x), r1 = bfhi(w.x), r2 = bflo(w.y), r3 = bfhi(w.y), r4 = bflo(w.z), r5 = bfhi(w.z), r6 = bflo(w.w), r7 = bfhi(w.w);
                        s += (r0 * r0 + r1 * r1) + (r2 * r2 + r3 * r3) + (r4 * r4 + r5 * r5) + (r6 * r6 + r7 * r7); }
                    s += __shfl_xor(s, 16); s += __shfl_xor(s, 32);
                    if (fq == 0) ssqp[(size_t)r * 16 + u.pn * 4 + wc] = s; }
                asm volatile("" ::: "memory"); }
    }
};
struct ScaleRow {
    static constexpr bool PERM = true, AFTER_DRAIN = false, HAS_MID = false;
    bf16* O; int ldc; const float* ssqp;
    __device__ __forceinline__ void operator()(const f32x4 (&acc)[2][2][4][2], const Unit& u, int wr, int wc, int fr, int fq) const {
        const int row0 = u.pm * 256 + wr * 64 + fr, c0 = u.pn * 256 + wc * 32 + 8 * fq;
        f32x4 pp[2][4];
#pragma unroll
        for (int ai = 0; ai < 2; ++ai)
#pragma unroll
            for (int m = 0; m < 4; ++m) pp[ai][m] = *(const f32x4*)(ssqp + (size_t)(row0 + ai * 128 + m * 16) * 16 + 4 * fq);
#pragma unroll
        for (int ai = 0; ai < 2; ++ai)
#pragma unroll
            for (int m = 0; m < 4; ++m) { const int r = row0 + ai * 128 + m * 16; float s = (pp[ai][m][0] + pp[ai][m][1]) + (pp[ai][m][2] + pp[ai][m][3]); s += __shfl_xor(s, 16); s += __shfl_xor(s, 32); const float rs = rstd_of(s);
#pragma unroll
                for (int bj = 0; bj < 2; ++bj) { const f32x4 v0 = acc[ai][bj][m][0] * rs, v1 = acc[ai][bj][m][1] * rs;
                    u32x4 w; w.x = pk2(v0[0], v0[1]); w.y = pk2(v0[2], v0[3]); w.z = pk2(v1[0], v1[1]); w.w = pk2(v1[2], v1[3]);
                    *(u32x4*)(O + (size_t)r * ldc + c0 + bj * 128) = w; } }
    }
};
struct SwiGLU {
    static constexpr bool PERM = true, AFTER_DRAIN = false, HAS_MID = false;
    bf16* ACT; const float* ssqp;
    __device__ __forceinline__ void operator()(const f32x4 (&acc)[2][2][4][2], const Unit& u, int wr, int wc, int fr, int fq) const {
        const int row0 = u.pm * 256 + wr * 64 + fr, c0 = u.pn * 128 + wc * 32 + 8 * fq;
        f32x4 pp[2][4];
#pragma unroll
        for (int ai = 0; ai < 2; ++ai)
#pragma unroll
            for (int m = 0; m < 4; ++m) pp[ai][m] = *(const f32x4*)(ssqp + (size_t)(row0 + ai * 128 + m * 16) * 16 + 4 * fq);
#pragma unroll
        for (int ai = 0; ai < 2; ++ai)
#pragma unroll
            for (int m = 0; m < 4; ++m) { const int r = row0 + ai * 128 + m * 16; float s = (pp[ai][m][0] + pp[ai][m][1]) + (pp[ai][m][2] + pp[ai][m][3]); s += __shfl_xor(s, 16); s += __shfl_xor(s, 32); const float rs = rstd_of(s);
                float h[8];
#pragma unroll
                for (int n = 0; n < 2; ++n)
#pragma unroll
                    for (int j = 0; j < 4; ++j) { const float g = acc[ai][0][m][n][j] * rs, up = acc[ai][1][m][n][j] * rs; h[4 * n + j] = g * fsigmoid(g) * up; }
                u32x4 w; w.x = pk2(h[0], h[1]); w.y = pk2(h[2], h[3]); w.z = pk2(h[4], h[5]); w.w = pk2(h[6], h[7]);
                *(u32x4*)(ACT + (size_t)r * DFF + c0) = w; }
    }
};
}

__device__ __forceinline__ void tr_item(const float* W, int ldw, int K, int k0, int sc0, bf16* WT, int dr0, const float* gain, float cs, LAS float* scr, int lane) {
#pragma unroll 16
    for (int i = 0; i < 32; ++i) { const int kk = 2 * i + (lane >> 5); const float g = gain ? gain[k0 + kk] * cs : cs;
        scr[kk * 33 + (lane & 31)] = W[(size_t)(k0 + kk) * ldw + sc0 + (lane & 31)] * g; }
    asm volatile("s_waitcnt lgkmcnt(0)" ::: "memory");
    const int c = lane & 7;
#pragma unroll
    for (int j = 0; j < 4; ++j) { const int n = (lane >> 3) + 8 * j; const LAS float* s = scr + (8 * c) * 33 + n;
        u32x4 o; o.x = pk2(s[0 * 33], s[1 * 33]); o.y = pk2(s[2 * 33], s[3 * 33]); o.z = pk2(s[4 * 33], s[5 * 33]); o.w = pk2(s[6 * 33], s[7 * 33]);
        *(u32x4*)(WT + (size_t)(dr0 + n) * K + k0 + 8 * c) = o; }
    asm volatile("s_waitcnt lgkmcnt(0)" ::: "memory");
}

struct Args { const float* in[20]; float* out; unsigned char* ws; };

__device__ __forceinline__ void xattn_unit(int tb, int h, const bf16* QX, const bf16* KX, const bf16* VXT, bf16* OX, int wid, int lane, LAS unsigned char* ldsl) {
    const int r32 = lane & 31, hi = lane >> 5, b = tb >> 3, tid = wid * 64 + lane;
    const size_t qrow = (size_t)tb * 256 + wid * 32 + r32;
    bf16x8 qr[8];
#pragma unroll
    for (int d0 = 0; d0 < 8; ++d0) qr[d0] = *(const bf16x8*)(QX + qrow * 512 + h * 128 + d0 * 16 + hi * 8);
    {
        u32x4 kt[8], vt[8];
#pragma unroll
        for (int i = 0; i < 8; ++i) { const int idx = tid + i * NTHR, key = idx >> 4, c = idx & 15; kt[i] = *(const u32x4*)(KX + ((size_t)b * 256 + key) * 512 + h * 128 + c * 8); }
#pragma unroll
        for (int i = 0; i < 8; ++i) { const int idx = tid + i * NTHR, d = idx >> 5, q = idx & 31; vt[i] = *(const u32x4*)(VXT + ((size_t)(b * 4 + h) * 128 + d) * 256 + q * 8); }
#pragma unroll
        for (int i = 0; i < 8; ++i) { const int idx = tid + i * NTHR, key = idx >> 4, c = idx & 15; *(LAS u32x4*)(ldsl + ((((key >> 5) * 16 + c) * 32 + (key & 31)) * 16)) = kt[i]; }
#pragma unroll
        for (int i = 0; i < 8; ++i) { const int idx = tid + i * NTHR, d = idx >> 5, q = idx & 31; *(LAS u32x4*)(ldsl + 65536 + (((((q >> 2) * 4 + (d >> 5)) * 4 + (q & 3)) * 32 + (d & 31)) * 16)) = vt[i]; }
    }
    __syncthreads();
    f32x16 o[4];
#pragma unroll
    for (int i = 0; i < 4; ++i) o[i] = f32x16{};
    float mrow = -1e30f, l = 0.f;
    const LAS unsigned char* kl = ldsl + (hi * 32 + r32) * 16;
    const LAS unsigned char* vl = ldsl + 65536 + (hi * 32 + r32) * 16;
#pragma unroll 2
    for (int kb = 0; kb < 8; ++kb) {
        f32x16 st = f32x16{};
#pragma unroll
        for (int d0 = 0; d0 < 8; ++d0) { const bf16x8 kf = *(const LAS bf16x8*)(kl + (kb * 16 + d0 * 2) * 512); st = __builtin_amdgcn_mfma_f32_32x32x16_bf16(kf, qr[d0], st, 0, 0, 0); }
        float mx = st[0];
#pragma unroll
        for (int r = 1; r < 16; ++r) mx = fmaxf(mx, st[r]);
        mx = fmaxf(mx, __shfl_xor(mx, 32));
        const float mn = fmaxf(mrow, mx), corr = __builtin_amdgcn_exp2f(mrow - mn); mrow = mn;
        float ps = 0.f;
#pragma unroll
        for (int r = 0; r < 16; ++r) { st[r] = __builtin_amdgcn_exp2f(st[r] - mn); ps += st[r]; }
        l = l * corr + ps;
#pragma unroll
        for (int db = 0; db < 4; ++db)
#pragma unroll
            for (int r = 0; r < 16; ++r) o[db][r] *= corr;
        u32x4 p0, p1;
        p0.x = pk2(st[0], st[1]); p0.y = pk2(st[2], st[3]); p0.z = pk2(st[4], st[5]); p0.w = pk2(st[6], st[7]);
        p1.x = pk2(st[8], st[9]); p1.y = pk2(st[10], st[11]); p1.z = pk2(st[12], st[13]); p1.w = pk2(st[14], st[15]);
        const bf16x8 pa0 = __builtin_bit_cast(bf16x8, p0), pa1 = __builtin_bit_cast(bf16x8, p1);
#pragma unroll
        for (int db = 0; db < 4; ++db) { const bf16x8 v0 = *(const LAS bf16x8*)(vl + ((kb * 4 + db) * 4) * 512), v1 = *(const LAS bf16x8*)(vl + ((kb * 4 + db) * 4 + 2) * 512);
            o[db] = __builtin_amdgcn_mfma_f32_32x32x16_bf16(v0, pa0, o[db], 0, 0, 0); o[db] = __builtin_amdgcn_mfma_f32_32x32x16_bf16(v1, pa1, o[db], 0, 0, 0); }
    }
    l += __shfl_xor(l, 32);
    const float inv = 1.0f / l;
    bf16* orow = OX + qrow * 512 + h * 128 + 4 * hi;
#pragma unroll
    for (int db = 0; db < 4; ++db)
#pragma unroll
        for (int jj = 0; jj < 4; ++jj) { u32x2 w; w.x = pk2(o[db][4 * jj] * inv, o[db][4 * jj + 1] * inv); w.y = pk2(o[db][4 * jj + 2] * inv, o[db][4 * jj + 3] * inv);
            *(u32x2*)(orow + db * 32 + 8 * jj) = w; }
    __syncthreads();
}

__device__ __forceinline__ void grid_bar(unsigned* ctr, unsigned target, bool leader) {
    asm volatile("s_waitcnt vmcnt(0) lgkmcnt(0)" ::: "memory");
    __syncthreads();
    if (leader) {
        __builtin_amdgcn_fence(__ATOMIC_RELEASE, "agent");
        asm volatile("s_waitcnt vmcnt(0)" ::: "memory");
        __hip_atomic_fetch_add(ctr, 1u, __ATOMIC_RELAXED, __HIP_MEMORY_SCOPE_AGENT);
        while (__hip_atomic_load(ctr, __ATOMIC_RELAXED, __HIP_MEMORY_SCOPE_AGENT) < target) __builtin_amdgcn_s_sleep(2);
        __builtin_amdgcn_fence(__ATOMIC_ACQUIRE, "agent");
        asm volatile("s_waitcnt vmcnt(0)" ::: "memory");
    }
    __syncthreads();
}
__device__ __forceinline__ void xcd_local_bar(unsigned* ctr, unsigned target, bool leader) {
    asm volatile("s_waitcnt vmcnt(0) lgkmcnt(0)" ::: "memory");
    __syncthreads();
    if (leader) {
        __hip_atomic_fetch_add(ctr, 1u, __ATOMIC_RELAXED, __HIP_MEMORY_SCOPE_AGENT);
        while (__hip_atomic_load(ctr, __ATOMIC_RELAXED, __HIP_MEMORY_SCOPE_AGENT) < target) __builtin_amdgcn_s_sleep(1);
        __builtin_amdgcn_fence(__ATOMIC_ACQUIRE, "agent");
        asm volatile("s_waitcnt vmcnt(0)" ::: "memory");
    }
    __syncthreads();
}
#ifndef REP_P0
#define REP_P0 1
#endif
#ifndef REP_P1
#define REP_P1 1
#endif
#ifndef REP_P2
#define REP_P2 1
#endif
#ifndef REP_P3
#define REP_P3 1
#endif
#ifndef REP_P4
#define REP_P4 1
#endif
#ifndef REP_P5A
#define REP_P5A 1
#endif
#ifndef REP_P5B
#define REP_P5B 1
#endif
#ifndef REP_P5C
#define REP_P5C 1
#endif
#ifndef REP_P6
#define REP_P6 1
#endif
#ifndef REP_P7
#define REP_P7 1
#endif
#ifndef REP_P8
#define REP_P8 1
#endif
#ifndef REP_P0T
#define REP_P0T 1
#endif
#ifndef REP_P0F
#define REP_P0F 1
#endif
#ifndef REP_P0R
#define REP_P0R 1
#endif
#ifndef REP_P1B
#define REP_P1B 1
#endif
__device__ __forceinline__ int opq(int k) { asm volatile("" : "+s"(k)); return k; }
typedef __attribute__((address_space(1))) unsigned char* gptr_t;
__device__ __forceinline__ gptr_t opq_ptr(const void* p) { gptr_t g = (gptr_t)p; asm volatile("" : "+s"(g)); return g; }
#define DECL_PTRS \
    gptr_t ws = opq_ptr(args.ws); \
    const int Gq = opq(G), bq = opq(blk), gw = bq * NWAVES + wave, NGW = Gq * NWAVES, hb = (Gq % 8 == 0) ? (bq % 8) * (Gq / 8) + bq / 8 : bq; (void)gw; (void)NGW; (void)hb; \
    const float* x = (const float*)opq_ptr(args.in[opq(0)]); const float* mem = (const float*)opq_ptr(args.in[opq(1)]); const float* norm_mix_g = (const float*)opq_ptr(args.in[opq(2)]); const float* w_in = (const float*)opq_ptr(args.in[opq(3)]); \
    const float* b_forget = (const float*)opq_ptr(args.in[opq(4)]); const float* b_gate = (const float*)opq_ptr(args.in[opq(5)]); const float* pool_w = (const float*)opq_ptr(args.in[opq(6)]); const float* pool_scale = (const float*)opq_ptr(args.in[opq(7)]); \
    const float* w_pool_out = (const float*)opq_ptr(args.in[opq(8)]); const float* w_fox_out = (const float*)opq_ptr(args.in[opq(9)]); const float* w_out = (const float*)opq_ptr(args.in[opq(10)]); const float* norm_x_g = (const float*)opq_ptr(args.in[opq(11)]); \
    const float* norm_mem_g = (const float*)opq_ptr(args.in[opq(12)]); const float* w_xq = (const float*)opq_ptr(args.in[opq(13)]); const float* w_xkv = (const float*)opq_ptr(args.in[opq(14)]); const float* w_xo = (const float*)opq_ptr(args.in[opq(15)]); \
    const float* norm_ffn_g = (const float*)opq_ptr(args.in[opq(16)]); const float* w_ffn_in = (const float*)opq_ptr(args.in[opq(17)]); const float* w_ffn_out = (const float*)opq_ptr(args.in[opq(18)]); const float* norm_final_g = (const float*)opq_ptr(args.in[opq(19)]); \
    float* out = (float*)opq_ptr(args.out); \
    bf16 *W1t = (bf16*)(ws + WS_W1), *Wmix = (bf16*)(ws + WS_WPC) , *Wout = (bf16*)(ws + WS_WOUT), *Wxq = (bf16*)(ws + WS_WXQ), *Wxkv = (bf16*)(ws + WS_WXKV), \
         *Wxo = (bf16*)(ws + WS_WXO), *Wffi = (bf16*)(ws + WS_WFFI), *Wffo = (bf16*)(ws + WS_WFFO), *MEMB = (bf16*)(ws + WS_MEMB), *KX = (bf16*)(ws + WS_KX), *VXT = (bf16*)(ws + WS_VXT); \
    float *LS = (float*)(ws + WS_LS), *CC = (float*)(ws + WS_C), *SSQ0 = (float*)(ws + WS_SSQ0), *SSQM = (float*)(ws + WS_SSQM), *SSQ1 = (float*)(ws + WS_SSQ1), *SSQ2 = (float*)(ws + WS_SSQ2), *SSQ3 = (float*)(ws + WS_SSQ3); \
    bf16 *XB = (bf16*)(ws + WS_RA), *AD = (bf16*)(ws + WS_RA), *X1B = (bf16*)(ws + WS_RA), *X2B = (bf16*)(ws + WS_RA); \
    bf16 *GT = (bf16*)(ws + WS_RB), *QX = (bf16*)(ws + WS_RB), *OX = (bf16*)(ws + WS_RB + 32 * MiB), *ACT = (bf16*)(ws + WS_RB); \
    bf16 *QF = (bf16*)(ws + WS_RC), *KF = (bf16*)(ws + WS_RC + 32 * MiB), *VF = (bf16*)(ws + WS_RC + 64 * MiB), *ZB = (bf16*)(ws + WS_RC); \
    bf16 *UB = (bf16*)(ws + WS_RD);
__global__ void __launch_bounds__(NTHR, 2) hybrid_fwd(Args args) {
    extern __shared__ __attribute__((aligned(16))) unsigned char lds[];
    cg::grid_group grid = cg::this_grid();
    LAS unsigned char* ldsl = (LAS unsigned char*)lds;
    const int wave = __builtin_amdgcn_readfirstlane((int)threadIdx.x >> 6);
    grid.sync();
    const int G = gridDim.x, blk = blockIdx.x;
    unsigned bar_target = 0;
#define GRID_BAR() do { bar_target += (unsigned)G; grid_bar((unsigned*)opq_ptr(args.ws), bar_target, wave == 0 && hw_lane() == 0); } while (0)
    unsigned xbar_target = 0;
    int use_xcd = 0;
    if (wave == 0 && hw_lane() == 0) __hip_atomic_store((unsigned*)opq_ptr(args.ws) + 2048 + blk, (unsigned)__builtin_amdgcn_s_getreg((3 << 11) | 20) & 0xFu, __ATOMIC_RELAXED, __HIP_MEMORY_SCOPE_AGENT);
#define XCD_BAR() do { if (use_xcd) { xbar_target += (unsigned)(G / 8); xcd_local_bar((unsigned*)opq_ptr(args.ws) + 64 * (1 + (blk & 7)), xbar_target, wave == 0 && hw_lane() == 0); } else GRID_BAR(); } while (0)
#ifndef SKIP_P0
    for (int rep_ = 0; rep_ < REP_P0; ++rep_) {
    DECL_PTRS
    (void)x; (void)mem; (void)out; (void)CC;
    {
        const int lane = hw_lane(), tid = wave * 64 + lane;
        LAS float* scr = (LAS float*)(ldsl + wave * 16384);
        constexpr int I0 = 16 * 128, I1 = 8 * 32, I2 = 16 * 32, I3 = 16 * 16, I4 = 16 * 32, I5 = 8 * 32, I6 = 16 * 176, I7 = 44 * 32;
        constexpr int NIT = I0 + I1 + I2 + I3 + I4 + I5 + I6 + I7;
        for (int rt_ = 0; rt_ < REP_P0T; ++rt_)
        for (int it = gw; it < NIT; it += NGW) {
            int r = it;
            if (r < I0) { const int kb = r / 128, nb = r % 128, n0 = 32 * nb; tr_item(w_in, INC, 1024, 64 * kb, n0 < 2048 ? n0 : n0 + 8, W1t, n0, norm_mix_g, 1.0f, scr, lane); continue; } r -= I0;
            if (r < I1) { const int kb = r / 32, nb = r % 32; tr_item(w_fox_out, 1024, 1024, 64 * kb, 32 * nb, Wmix + 512, 32 * nb, nullptr, 1.0f, scr, lane); continue; } r -= I1;
            if (r < I2) { const int kb = r / 32, nb = r % 32; tr_item(w_out, 1024, 1024, 64 * kb, 32 * nb, Wout, 32 * nb, nullptr, 1.0f, scr, lane); continue; } r -= I2;
            if (r < I3) { const int kb = r / 16, nb = r % 16; tr_item(w_xq, 512, 1024, 64 * kb, 32 * nb, Wxq, 32 * nb, norm_x_g, 0.08838834764831845f * LOG2E, scr, lane); continue; } r -= I3;
            if (r < I4) { const int kb = r / 32, nb = r % 32; tr_item(w_xkv, 1024, 1024, 64 * kb, 32 * nb, Wxkv, 32 * nb, norm_mem_g, 1.0f, scr, lane); continue; } r -= I4;
            if (r < I5) { const int kb = r / 32, nb = r % 32; tr_item(w_xo, 1024, 512, 64 * kb, 32 * nb, Wxo, 32 * nb, nullptr, 1.0f, scr, lane); continue; } r -= I5;
            if (r < I6) { const int kb = r / 176, nb = r % 176, n0 = 32 * nb, j = n0 >> 8, wi = n0 & 255; const int sc = wi < 128 ? 128 * j + wi : DFF + 128 * j + (wi - 128);
                          tr_item(w_ffn_in, 2 * DFF, 1024, 64 * kb, sc, Wffi, n0, norm_ffn_g, 1.0f, scr, lane); continue; } r -= I6;
            { const int kb = r / 32, nb = r % 32; tr_item(w_ffn_out, 1024, DFF, 64 * kb, 32 * nb, Wffo, 32 * nb, nullptr, 1.0f, scr, lane); }
        }
        for (int rf_ = 0; rf_ < REP_P0F; ++rf_)
        for (int bi = blk; bi < 128; bi += G) { const int nb = bi >> 3, kl = bi & 7, k0 = kl * 64 + wave * 8, gb = (k0 >> 7) * 128, n = nb * 64 + lane;
            float a[8];
#pragma unroll
            for (int kk = 0; kk < 8; ++kk) a[kk] = 0.f;
#pragma unroll 8
            for (int d = 0; d < 128; ++d) { const float wv = w_pool_out[(size_t)(gb + d) * 1024 + n] * pool_scale[gb + d];
#pragma unroll
                for (int kk = 0; kk < 8; ++kk) a[kk] += pool_w[(size_t)(k0 + kk) * 128 + d] * wv; }
            u32x4 o; o.x = pk2(a[0], a[1]); o.y = pk2(a[2], a[3]); o.z = pk2(a[4], a[5]); o.w = pk2(a[6], a[7]);
            *(u32x4*)(Wmix + (size_t)n * 1024 + k0) = o; }
        __syncthreads();
        LAS float* gwt = (LAS float*)ldsl;
#pragma unroll
        for (int i = 0; i < 16; ++i) { const int idx = tid + i * NTHR, h = idx & 7, k = idx >> 3; gwt[h * 1024 + k] = norm_mix_g[k] * w_in[(size_t)k * INC + 2048 + h]; }
        __syncthreads();
        const int rpb = (T + G - 1) / G, rpw = (rpb + NWAVES - 1) / NWAVES;
        for (int rr_ = 0; rr_ < REP_P0R; ++rr_)
        {
            (void)rpw;
            f32x4 v[4], nx[4];
            if (gw < T) {
#pragma unroll
                for (int j = 0; j < 4; ++j) nx[j] = ((const f32x4*)(x + (size_t)gw * DM) + lane)[64 * j]; }
            for (int row = gw; row < T; row += NGW) {
#pragma unroll
                for (int j = 0; j < 4; ++j) v[j] = nx[j];
                if (row + NGW < T) {
#pragma unroll
                    for (int j = 0; j < 4; ++j) nx[j] = ((const f32x4*)(x + (size_t)(row + NGW) * DM) + lane)[64 * j]; }
                float s = 0.f;
#pragma unroll
                for (int j = 0; j < 4; ++j) s += (v[j][0] * v[j][0] + v[j][1] * v[j][1]) + (v[j][2] * v[j][2] + v[j][3] * v[j][3]);
                unsigned long long* o8 = (unsigned long long*)(XB + (size_t)row * DM) + lane;
#pragma unroll
                for (int j = 0; j < 4; ++j) o8[64 * j] = (unsigned long long)pk2(v[j][0], v[j][1]) | ((unsigned long long)pk2(v[j][2], v[j][3]) << 32);
                float d[8];
#pragma unroll
                for (int h = 0; h < 8; ++h) { d[h] = 0.f;
#pragma unroll
                    for (int j = 0; j < 4; ++j) { const f32x4 g4 = *(const LAS f32x4*)(gwt + h * 1024 + 256 * j + 4 * lane); d[h] += (v[j][0] * g4[0] + v[j][1] * g4[1]) + (v[j][2] * g4[2] + v[j][3] * g4[3]); } }
                s = wave_sum(s);
                { const bool u5 = (lane & 32) != 0, u4 = (lane & 16) != 0, u3 = (lane & 8) != 0;
#pragma unroll
                  for (int i = 0; i < 4; ++i) { const float keep = u5 ? d[i + 4] : d[i], send = u5 ? d[i] : d[i + 4]; d[i] = keep + __shfl_xor(send, 32); }
#pragma unroll
                  for (int i = 0; i < 2; ++i) { const float keep = u4 ? d[i + 2] : d[i], send = u4 ? d[i] : d[i + 2]; d[i] = keep + __shfl_xor(send, 16); }
                  { const float keep = u3 ? d[1] : d[0], send = u3 ? d[0] : d[1]; d[0] = keep + __shfl_xor(send, 8); }
                  d[0] += __shfl_xor(d[0], 4); d[0] += __shfl_xor(d[0], 2); d[0] += __shfl_xor(d[0], 1); }
                const float rs = 1.0f / sqrtf(s * (1.0f / DM) + EPS);
                if (lane == 0) SSQ0[row] = s;
                if ((lane & 7) == 0) { const int h = lane >> 3; const float z = d[0] * rs + b_forget[h]; const float lsv = fminf(z, 0.f) - log1pf(expf(-fabsf(z)));
                    const int bb = row >> 11, sp = row & 2047; __hip_atomic_store(LS + ((size_t)bb * 8 + h) * SEQ + sp, lsv, __ATOMIC_RELAXED, __HIP_MEMORY_SCOPE_AGENT); }
            }
        }
        for (int row = gw; row < TM; row += NGW) {
            const f32x4* xr = (const f32x4*)(mem + (size_t)row * DM) + lane; float s = 0.f;
            unsigned long long* o8 = (unsigned long long*)(MEMB + (size_t)row * DM) + lane;
#pragma unroll
            for (int j = 0; j < 4; ++j) { const f32x4 v = xr[64 * j]; s += (v[0] * v[0] + v[1] * v[1]) + (v[2] * v[2] + v[3] * v[3]);
                o8[64 * j] = (unsigned long long)pk2(v[0], v[1]) | ((unsigned long long)pk2(v[2], v[3]) << 32); }
            s = wave_sum(s); if (lane == 0) SSQM[row] = s;
        }
    }
    GRID_BAR();
    if (rep_ == REP_P0 - 1) {
        volatile LAS int* flagw = (volatile LAS int*)(ldsl + LDS_BYTES - 64);
        if (wave == 0) { const int l_ = hw_lane(); const unsigned* xt = (const unsigned*)opq_ptr(args.ws) + 2048; const unsigned mine = __hip_atomic_load(xt + blk, __ATOMIC_RELAXED, __HIP_MEMORY_SCOPE_AGENT); int ok = (G % 8 == 0);
            for (int b2 = l_; b2 < G; b2 += 64) { const unsigned o = __hip_atomic_load(xt + b2, __ATOMIC_RELAXED, __HIP_MEMORY_SCOPE_AGENT); if ((o == mine) != ((b2 & 7) == (blk & 7))) ok = 0; }
            ok = __all(ok); if (l_ == 0) *flagw = ok; }
        __syncthreads();
        use_xcd = __builtin_amdgcn_readfirstlane(*flagw);
        __syncthreads();
    }

    }
#endif
#ifndef SKIP_P1
    for (int rep_ = 0; rep_ < REP_P1; ++rep_) {
    DECL_PTRS
    (void)x; (void)mem; (void)out; (void)CC;
    {
        const int lane = hw_lane();
        for (int rb_ = 0; rb_ < REP_P1B; ++rb_)
        { pg8::Gemm g{XB, W1t, T, 4096, 1024}; pg8::StaticOrder S; S.init(T, 4096, G, blk);
          epi::InProj E{UB, QF, KF, VF, GT, SSQ0, b_gate};
          pg8::gemm_phase<epi::InProj, pg8::StaticOrder, PG8_ALIGN, PG8_SP2>(ldsl, g, S, E, wave); }
        { pg8::Gemm g{MEMB, Wxkv, TM, 1024, 1024}; pg8::StaticOrder S; S.init(TM, 1024, G, blk);
          epi::MemKV E{KX, VXT, SSQM};
          pg8::gemm_phase<epi::MemKV, pg8::StaticOrder, PG8_ALIGN, PG8_SP2>(ldsl, g, S, E, wave);
          pg8::Unit u0_; int nmine = 0; for (int i = 0; S.next(i, u0_); ++i) ++nmine;
          if (nmine > 0) { asm volatile("s_waitcnt vmcnt(0)" ::: "memory"); __syncthreads();
            if (wave == 0 && hw_lane() == 0) { __builtin_amdgcn_fence(__ATOMIC_RELEASE, "agent"); asm volatile("s_waitcnt vmcnt(0)" ::: "memory");
              __hip_atomic_fetch_add((unsigned*)opq_ptr(args.ws) + 64 * 10, (unsigned)nmine, __ATOMIC_RELAXED, __HIP_MEMORY_SCOPE_AGENT); } } }
    }
    if (use_xcd) XCD_BAR(); else GRID_BAR();

    }
#endif
#ifndef SKIP_P2
    for (int rep_ = 0; rep_ < REP_P2; ++rep_) {
    DECL_PTRS
    (void)x; (void)mem; (void)out; (void)CC;
    {
        const int lane = hw_lane();
        const int rpb = (T + G - 1) / G, rows_per = (rpb + NWAVES - 1) / NWAVES;
        const int gI = lane >> 4, w = 2 << gI;
        const int t_b = hb * rpb + wave * rows_per; int nr = rpb - wave * rows_per; if (nr > rows_per) nr = rows_per; if (t_b + nr > T) nr = T - t_b;
        u32x4 qn[16];
        if (nr > 0) { const int sp0 = t_b & 2047, c0_ = (sp0 + 1) < w ? (sp0 + 1) : w;
#pragma unroll
            for (int j = 0; j < 16; ++j) qn[j] = *(const u32x4*)(UB + (size_t)(j < c0_ ? t_b - j : t_b) * 512 + lane * 8); }
        for (int i = 0; i < nr; ++i) { const int t = t_b + i;
            const int sp = t & 2047, cnt = (sp + 1) < w ? (sp + 1) : w;
            u32x4 qv[16];
#pragma unroll
            for (int j = 0; j < 16; ++j) qv[j] = qn[j];
            if (i + 1 < nr) { const int t1 = t + 1, sp1 = t1 & 2047, c1_ = (sp1 + 1) < w ? (sp1 + 1) : w;
#pragma unroll
                for (int j = 0; j < 16; ++j) qn[j] = *(const u32x4*)(UB + (size_t)(j < c1_ ? t1 - j : t1) * 512 + lane * 8); }
            float a[8];
#pragma unroll
            for (int e = 0; e < 8; ++e) a[e] = 0.f;
            const u32x4 u0 = qv[0];
#pragma unroll
            for (int j = 0; j < 16; ++j) { const float mk = j < cnt ? 1.0f : 0.0f; const u32x4 q = qv[j];
                a[0] += mk * bflo(q.x); a[1] += mk * bfhi(q.x); a[2] += mk * bflo(q.y); a[3] += mk * bfhi(q.y); a[4] += mk * bflo(q.z); a[5] += mk * bfhi(q.z); a[6] += mk * bflo(q.w); a[7] += mk * bfhi(q.w); }
            const float ic = 1.0f / (float)cnt;
            u32x4 o; o.x = pk2(a[0] * ic - bflo(u0.x), a[1] * ic - bfhi(u0.x)); o.y = pk2(a[2] * ic - bflo(u0.y), a[3] * ic - bfhi(u0.y));
            o.z = pk2(a[4] * ic - bflo(u0.z), a[5] * ic - bfhi(u0.z)); o.w = pk2(a[6] * ic - bflo(u0.w), a[7] * ic - bfhi(u0.w));
            *(u32x4*)(AD + (size_t)t * 1024 + lane * 8) = o; }
        __syncthreads();
        const attn_body::AttnTensors AT{(const attn_body::bf16*)QF, (const attn_body::bf16*)KF, (const attn_body::bf16*)VF, (attn_body::bf16*)(AD + 512), LS};
        const attn_body::StaticOrder S(G, blk);
        attn_body::attn_phase<attn_body::StaticOrder, 40>((char*)lds, AT, S, wave);
    }
    XCD_BAR();

    }
#endif
#ifndef SKIP_P3
    for (int rep_ = 0; rep_ < REP_P3; ++rep_) {
    DECL_PTRS
    (void)x; (void)mem; (void)out; (void)CC;
    { pg8::Gemm g{AD, Wmix, T, 1024, 1024}; pg8::StaticOrder S; S.init(T, 1024, G, blk);
      epi::Mix E{GT, ZB};
      pg8::gemm_phase<epi::Mix, pg8::StaticOrder, PG8_ALIGN, PG8_SP2>(ldsl, g, S, E, wave); }
    XCD_BAR();

    }
#endif
#ifndef SKIP_P4
    for (int rep_ = 0; rep_ < REP_P4; ++rep_) {
    DECL_PTRS
    (void)x; (void)mem; (void)out; (void)CC;
    { pg8::Gemm g{ZB, Wout, T, 1024, 1024}; pg8::StaticOrder S; S.init(T, 1024, G, blk);
      epi::Resid<false> E{x, X1B, SSQ1};
      pg8::gemm_phase<epi::Resid<false>, pg8::StaticOrder, PG8_ALIGN, PG8_SP2>(ldsl, g, S, E, wave); }
    XCD_BAR();

    }
#endif
#ifndef SKIP_P5A
    for (int rep_ = 0; rep_ < REP_P5A; ++rep_) {
    DECL_PTRS
    (void)x; (void)mem; (void)out; (void)CC;
    { pg8::Gemm g{X1B, Wxq, T, 512, 1024}; pg8::StaticOrder S; S.init(T, 512, G, blk);
      epi::ScaleRow E{QX, 512, SSQ1};
      pg8::gemm_phase<epi::ScaleRow, pg8::StaticOrder, PG8_ALIGN, PG8_SP2>(ldsl, g, S, E, wave); }
    XCD_BAR();

    }
#endif
#ifndef SKIP_P5B
    for (int rep_ = 0; rep_ < REP_P5B; ++rep_) {
    DECL_PTRS
    (void)x; (void)mem; (void)out; (void)CC;
    if (use_xcd) { if (wave == 0 && hw_lane() == 0) { while (__hip_atomic_load((unsigned*)opq_ptr(args.ws) + 64 * 10, __ATOMIC_RELAXED, __HIP_MEMORY_SCOPE_AGENT) < (unsigned)((TM / 256) * 4)) __builtin_amdgcn_s_sleep(2);
          __builtin_amdgcn_fence(__ATOMIC_ACQUIRE, "agent"); asm volatile("s_waitcnt vmcnt(0)" ::: "memory"); }
      __syncthreads(); }
    { const int lane = hw_lane(); const int upb = ((T / 256) * 4 + G - 1) / G; for (int i = 0; i < upb; ++i) { const int un = hb * upb + i; if (un >= (T / 256) * 4) break; xattn_unit(un >> 2, un & 3, QX, KX, VXT, OX, wave, lane, ldsl); } }
    XCD_BAR();

    }
#endif
#ifndef SKIP_P5C
    for (int rep_ = 0; rep_ < REP_P5C; ++rep_) {
    DECL_PTRS
    (void)x; (void)mem; (void)out; (void)CC;
    { pg8::Gemm g{OX, Wxo, T, 1024, 512}; pg8::StaticOrder S; S.init(T, 1024, G, blk);
      epi::Resid<true> E{X1B, X2B, SSQ2};
      pg8::gemm_phase<epi::Resid<true>, pg8::StaticOrder, PG8_ALIGN, PG8_SP2>(ldsl, g, S, E, wave); }
    XCD_BAR();

    }
#endif
#ifndef SKIP_P6
    for (int rep_ = 0; rep_ < REP_P6; ++rep_) {
    DECL_PTRS
    (void)x; (void)mem; (void)out; (void)CC;
    { pg8::Gemm g{X2B, Wffi, T, 2 * DFF, 1024}; pg8::StaticOrder S; S.init(T, 2 * DFF, G, blk);
      epi::SwiGLU E{ACT, SSQ2};
      pg8::gemm_phase<epi::SwiGLU, pg8::StaticOrder, PG8_ALIGN, PG8_SP2>(ldsl, g, S, E, wave); }
    XCD_BAR();

    }
#endif
#ifndef SKIP_P7
    for (int rep_ = 0; rep_ < REP_P7; ++rep_) {
    DECL_PTRS
    (void)x; (void)mem; (void)out; (void)CC;
    { pg8::Gemm g{ACT, Wffo, T, 1024, DFF}; pg8::StaticOrder S; S.init(T, 1024, G, blk);
      epi::Resid<true> E{X2B, X2B, SSQ3};
      pg8::gemm_phase<epi::Resid<true>, pg8::StaticOrder, PG8_ALIGN, PG8_SP2>(ldsl, g, S, E, wave); }
    XCD_BAR();

    }
#endif
#ifndef SKIP_P8
    for (int rep_ = 0; rep_ < REP_P8; ++rep_) {
    DECL_PTRS
    (void)x; (void)mem; (void)out; (void)CC;
    { const int lane = hw_lane();
    const int rpb = (T + G - 1) / G, rpw = (rpb + NWAVES - 1) / NWAVES;
    const int row_b = hb * rpb + wave * rpw; int nrows = rpb - wave * rpw; if (nrows > rpw) nrows = rpw; if (row_b + nrows > T) nrows = T - row_b;
    f32x4 gv[4];
#pragma unroll
    for (int j = 0; j < 4; ++j) gv[j] = ((const f32x4*)norm_final_g + lane)[64 * j];
    f32x4 pa_n = {0.f, 0.f, 0.f, 0.f}; unsigned long long q_n[4] = {0ull, 0ull, 0ull, 0ull};
    if (nrows > 0) { pa_n = *(const f32x4*)(SSQ3 + (size_t)row_b * 16 + 4 * (lane & 3));
#pragma unroll
        for (int j = 0; j < 4; ++j) q_n[j] = ((const unsigned long long*)(X2B + (size_t)row_b * DM) + lane)[64 * j]; }
    for (int k = 0; k < nrows; ++k) { const int row = row_b + k;
        const f32x4 pa = pa_n; unsigned long long q[4];
#pragma unroll
        for (int j = 0; j < 4; ++j) q[j] = q_n[j];
        if (k + 1 < nrows) { pa_n = *(const f32x4*)(SSQ3 + (size_t)(row + 1) * 16 + 4 * (lane & 3));
#pragma unroll
            for (int j = 0; j < 4; ++j) q_n[j] = ((const unsigned long long*)(X2B + (size_t)(row + 1) * DM) + lane)[64 * j]; }
        float s = (pa[0] + pa[1]) + (pa[2] + pa[3]); s += __shfl_xor(s, 1); s += __shfl_xor(s, 2);
        const float rs = 1.0f / sqrtf(s * (1.0f / DM) + EPS);
        f32x4* orow = (f32x4*)(out + (size_t)row * DM) + lane;
#pragma unroll
        for (int j = 0; j < 4; ++j) { const unsigned lo = (unsigned)q[j], hi = (unsigned)(q[j] >> 32);
            orow[64 * j] = (f32x4){bflo(lo), bfhi(lo), bflo(hi), bfhi(hi)} * rs * gv[j]; }
    } }
    }
#endif
}

extern "C" void kernel_launch(void* const* d_in, const int* in_sizes, int n_in, void* d_out, int out_size, void* d_ws, size_t ws_size, hipStream_t stream) {
    static int grid = 0;
    if (grid == 0) {
        if (n_in != 20 || in_sizes[0] != T * DM || out_size != T * DM || ws_size < WS_END) { fprintf(stderr, "kernel_launch: unexpected shapes (n_in %d, in0 %d, out %d, ws %zu)\n", n_in, n_in > 0 ? in_sizes[0] : -1, out_size, ws_size); grid = -1; return; }
        int dev = 0, cus = 0, per_cu = 0;
        if (hipGetDevice(&dev) != hipSuccess || hipDeviceGetAttribute(&cus, hipDeviceAttributeMultiprocessorCount, dev) != hipSuccess) { grid = -1; return; }
        if (hipFuncSetAttribute((const void*)hybrid_fwd, hipFuncAttributeMaxDynamicSharedMemorySize, LDS_BYTES) != hipSuccess) { fprintf(stderr, "kernel_launch: hipFuncSetAttribute failed\n"); grid = -1; return; }
        if (hipOccupancyMaxActiveBlocksPerMultiprocessor(&per_cu, (const void*)hybrid_fwd, NTHR, LDS_BYTES) != hipSuccess || per_cu < 1) { fprintf(stderr, "kernel_launch: occupancy query says %d blocks per CU\n", per_cu); (void)hipGetLastError(); grid = -1; return; }
        grid = cus * per_cu; if (grid > 256) grid = 256;
    }
    if (grid < 0) return;
    Args a{};
    for (int i = 0; i < 20; ++i) a.in[i] = (const float*)d_in[i];
    a.out = (float*)d_out; a.ws = (unsigned char*)d_ws;
    if (hipMemsetAsync(d_ws, 0, 4096, stream) != hipSuccess) { fprintf(stderr, "kernel_launch: memset failed\n"); return; }
    void* kargs[] = {&a};
    hipError_t e = hipLaunchCooperativeKernel((const void*)hybrid_fwd, dim3(grid), dim3(NTHR), kargs, LDS_BYTES, stream);
    if (e != hipSuccess) fprintf(stderr, "kernel_launch: cooperative launch failed: %s (grid %d)\n", hipGetErrorString(e), grid);
}
```
